# Optimizing an MI355X kernel written in HIP

```python
import math
import jax
import jax.numpy as jnp
from jax import lax
import numpy as np

D_MODEL = 1024
BATCH = 16
SEQ = 4096
DEPTH = 4
DEC_BATCH = 8
DEC_SEQ = 64
PAST_LEN = 2048

CHUNK = 64
N_MEM = 256
H_GDN = 4
DK_GDN = D_MODEL // (2 * H_GDN)
DV_GDN = D_MODEL // (2 * H_GDN)
CONV_W = 4
W_GDN_QK = H_GDN * DK_GDN
W_GDN_V = H_GDN * DV_GDN
CONV_CH = 2 * W_GDN_QK + W_GDN_V
H_DIFF = 4
D_DIFF = D_MODEL // (4 * H_DIFF)
W_DIFF = H_DIFF * 2 * D_DIFF
MIX_W = W_GDN_V + W_DIFF
H_MEM = 4
D_MEM = D_MODEL // H_MEM
D_FF = 4 * D_MODEL
Q_BLOCK = 128
EPS = 1e-6
SPLIT_AT = (CONV_CH, CONV_CH + W_GDN_V, CONV_CH + W_GDN_V + H_GDN, CONV_CH + W_GDN_V + 2 * H_GDN,
            CONV_CH + W_GDN_V + 2 * H_GDN + W_DIFF, CONV_CH + W_GDN_V + 2 * H_GDN + 2 * W_DIFF)
IN_COLS = CONV_CH + W_GDN_V + 2 * H_GDN + 3 * W_DIFF

kernel_name = 'hymba_gdn_diffattn_streaming_step'


def _rmsnorm(x, g):
    xf = x.astype(jnp.float32)
    y = xf * lax.rsqrt(jnp.mean(xf * xf, axis=-1, keepdims=True) + EPS)
    return (y * g.astype(jnp.float32)).astype(x.dtype)


def _l2norm(x):
    return x * lax.rsqrt(jnp.sum(x * x, axis=-1, keepdims=True) + EPS)


def _causal_conv(x, w, buf):
    L = x.shape[1]
    xp = jnp.concatenate([buf.astype(x.dtype), x], axis=1)
    y = w[0] * xp[:, 0:L]
    for i in range(1, CONV_W):
        y = y + w[i] * xp[:, i:i + L]
    return y, xp[:, L:]


def _gdn_chunked(q, k, v, g, beta, S0):
    B, L, H, DK = q.shape
    DV = v.shape[-1]
    C = min(CHUNK, L)
    n = L // C

    def blocks(t):
        t = t.reshape((B, n, C, H) + t.shape[3:])
        return jnp.moveaxis(jnp.moveaxis(t, 1, 0), 3, 2)

    qc, kc, vc, gc, bc = blocks(q), blocks(k), blocks(v), blocks(g), blocks(beta)
    G = jnp.cumsum(gc, axis=-1)
    tril = jnp.tril(jnp.ones((C, C), bool))
    strict = jnp.tril(jnp.ones((C, C), bool), -1)
    diff = G[..., :, None] - G[..., None, :]
    gam = jnp.where(tril, jnp.exp(jnp.where(tril, diff, 0.0)), 0.0)
    kk = jnp.einsum('nbhid,nbhjd->nbhij', kc, kc)
    a_sys = jnp.where(strict, bc[..., :, None] * kk * gam, 0.0) + jnp.eye(C, dtype=jnp.float32)
    u = lax.linalg.triangular_solve(a_sys, bc[..., None] * vc, left_side=True, lower=True, unit_diagonal=True)
    w = lax.linalg.triangular_solve(a_sys, (bc * jnp.exp(G))[..., None] * kc, left_side=True, lower=True,
                                    unit_diagonal=True)
    qk = jnp.einsum('nbhid,nbhjd->nbhij', qc, kc) * gam
    qg = qc * jnp.exp(G)[..., None]
    kd = kc * jnp.exp(G[..., -1:] - G)[..., None]
    gl = jnp.exp(G[..., -1])

    def step(S, xs):
        u_c, w_c, qk_c, qg_c, kd_c, gl_c = xs
        vn = u_c - jnp.einsum('bhcd,bhde->bhce', w_c, S)
        o = jnp.einsum('bhcd,bhde->bhce', qg_c, S) + jnp.einsum('bhij,bhje->bhie', qk_c, vn)
        S = S * gl_c[..., None, None] + jnp.einsum('bhcd,bhce->bhde', kd_c, vn)
        return S, o

    S, o = lax.scan(step, S0, (u, w, qk, qg, kd, gl))
    o = jnp.moveaxis(jnp.moveaxis(o, 2, 3), 0, 1).reshape(B, L, H, DV)
    return o, S


def _diff_attention(q, k, v, q_pos, k_pos, lam):
    B, Lq = q.shape[0], q.shape[1]
    n_blk = max(Lq // Q_BLOCK, 1)
    blk = Lq // n_blk
    qb = jnp.moveaxis(q.reshape((B, n_blk, blk) + q.shape[2:]), 1, 0)
    pb = q_pos.reshape(n_blk, blk)
    kf = k.astype(jnp.float32)
    vf = v.astype(jnp.float32)
    scale = D_DIFF ** -0.5

    def one(args):
        qi, pi = args
        s = jnp.einsum('bqhcd,bkhcd->bhcqk', qi.astype(jnp.float32), kf) * scale
        visible = k_pos[None, :] < ((pi // CHUNK + 1) * CHUNK)[:, None]
        s = jnp.where(visible, s, -jnp.inf)
        p = jax.nn.softmax(s, axis=-1)
        a = p[:, :, 0] - lam * p[:, :, 1]
        return jnp.einsum('bhqk,bkhe->bqhe', a, vf)

    o = lax.map(one, (qb, pb))
    return jnp.moveaxis(o, 0, 1).reshape(B, Lq, H_DIFF, 2 * D_DIFF)


def _mem_kv(mem, g, wk, wv):
    B, M, _ = mem.shape
    m = _rmsnorm(mem, g)
    return (m @ wk).reshape(B, M, H_MEM, D_MEM), (m @ wv).reshape(B, M, H_MEM, D_MEM)


def _mem_attn(x, mk, mv, wq, wo):
    B, L, _ = x.shape
    q = (x @ wq).reshape(B, L, H_MEM, D_MEM)
    s = jnp.einsum('blhd,bmhd->bhlm', q.astype(jnp.float32), mk.astype(jnp.float32)) * (D_MEM ** -0.5)
    p = jax.nn.softmax(s, axis=-1)
    o = jnp.einsum('bhlm,bmhd->blhd', p, mv.astype(jnp.float32)).astype(x.dtype)
    return o.reshape(B, L, D_MODEL) @ wo


def _layer(x, mem_k, mem_v, kc, vc, S0, conv_buf, lam_init, p):
    B, L, _ = x.shape
    dt = x.dtype
    xn = _rmsnorm(x, p['ln_mix'])
    proj = xn @ p['w_in']
    conv_in, z, a, b, qd, kd, vd = jnp.split(proj, SPLIT_AT, axis=-1)
    c, conv_new = _causal_conv(conv_in, p['conv_w'], conv_buf)
    c = jax.nn.silu(c.astype(jnp.float32))
    qa, ka, va = jnp.split(c, (W_GDN_QK, 2 * W_GDN_QK), axis=-1)
    qa = _l2norm(qa.reshape(B, L, H_GDN, DK_GDN)) * (DK_GDN ** -0.5)
    ka = _l2norm(ka.reshape(B, L, H_GDN, DK_GDN))
    va = va.reshape(B, L, H_GDN, DV_GDN)
    g = -jnp.exp(p['a_log'].astype(jnp.float32)) * jax.nn.softplus(a.astype(jnp.float32) + p['dt_bias'].astype(jnp.float32))
    beta = jax.nn.sigmoid(b.astype(jnp.float32))
    oa, S_new = _gdn_chunked(qa, ka, va, g, beta, S0.astype(jnp.float32))
    oa = _rmsnorm(oa, p['gdn_norm']) * jax.nn.silu(z.astype(jnp.float32).reshape(B, L, H_GDN, DV_GDN))
    oa = oa.reshape(B, L, W_GDN_V).astype(dt)
    kd = kd.reshape(B, L, H_DIFF, 2 * D_DIFF)
    vd = vd.reshape(B, L, H_DIFF, 2 * D_DIFF)
    if kc is None:
        k_all, v_all = kd, vd
    else:
        k_all = jnp.concatenate([kc.astype(dt), kd], axis=1)
        v_all = jnp.concatenate([vc.astype(dt), vd], axis=1)
    Lk = k_all.shape[1]
    k_pos = jnp.arange(Lk)
    q_pos = Lk - L + jnp.arange(L)
    lam = (jnp.exp(jnp.sum(p['lq1'].astype(jnp.float32) * p['lk1'].astype(jnp.float32)))
           - jnp.exp(jnp.sum(p['lq2'].astype(jnp.float32) * p['lk2'].astype(jnp.float32))) + lam_init)
    ob = _diff_attention(qd.reshape(B, L, H_DIFF, 2, D_DIFF), k_all.reshape(B, Lk, H_DIFF, 2, D_DIFF),
                         v_all, q_pos, k_pos, lam)
    ob = (_rmsnorm(ob, p['diff_norm']) * (1.0 - lam_init)).reshape(B, L, W_DIFF).astype(dt)
    h = x + jnp.concatenate([oa, ob], axis=-1) @ p['w_out']
    h = h + _mem_attn(_rmsnorm(h, p['ln_mem_q']), mem_k, mem_v, p['w_mem_q'], p['w_mem_o'])
    hn = _rmsnorm(h, p['ln_ffn'])
    h = h + jnp.square(jax.nn.relu(hn @ p['w_ff1'])) @ p['w_ff2']
    return h, kd, vd, S_new.astype(dt), conv_new


def setup_inputs(seed: int = 0) -> dict:
    key = jax.random.key(seed)
    ks = jax.random.split(key, 40)
    f32 = jnp.float32

    def nrm(k, shape, s):
        return jax.random.normal(k, shape, f32) * s

    def gain(k, shape):
        return 1.0 + 0.02 * jax.random.normal(k, shape, f32)

    dt0 = jnp.exp(jax.random.uniform(ks[9], (DEPTH, H_GDN), f32, math.log(1e-3), math.log(1e-1)))
    return {
        'x_prompt': nrm(ks[0], (BATCH, SEQ, D_MODEL), 1.0),
        'x_sample': nrm(ks[1], (DEC_BATCH, DEC_SEQ, D_MODEL), 1.0),
        'mem_prompt': nrm(ks[2], (BATCH, N_MEM, D_MODEL), 1.0),
        'cache_diff_k': nrm(ks[3], (DEPTH, DEC_BATCH, PAST_LEN, H_DIFF, 2 * D_DIFF), 1.0),
        'cache_diff_v': nrm(ks[4], (DEPTH, DEC_BATCH, PAST_LEN, H_DIFF, 2 * D_DIFF), 1.0),
        'cache_mem_k': nrm(ks[5], (DEPTH, DEC_BATCH, N_MEM, H_MEM, D_MEM), 1.0),
        'cache_mem_v': nrm(ks[6], (DEPTH, DEC_BATCH, N_MEM, H_MEM, D_MEM), 1.0),
        'state_gdn': nrm(ks[7], (DEPTH, DEC_BATCH, H_GDN, DK_GDN, DV_GDN), DK_GDN ** -0.5),
        'state_gdn_conv': nrm(ks[8], (DEPTH, DEC_BATCH, CONV_W - 1, CONV_CH), 1.0),
        'ln_mix': gain(ks[10], (DEPTH, D_MODEL)),
        'w_in': nrm(ks[11], (DEPTH, D_MODEL, IN_COLS), D_MODEL ** -0.5),
        'conv_w': nrm(ks[12], (DEPTH, CONV_W, CONV_CH), CONV_W ** -0.5),
        'a_log': jnp.log(jax.random.uniform(ks[13], (DEPTH, H_GDN), f32, 1.0, 16.0)),
        'dt_bias': dt0 + jnp.log(-jnp.expm1(-dt0)),
        'gdn_norm': gain(ks[14], (DEPTH, DV_GDN)),
        'lambda_q1': nrm(ks[15], (DEPTH, D_DIFF), 0.1),
        'lambda_k1': nrm(ks[16], (DEPTH, D_DIFF), 0.1),
        'lambda_q2': nrm(ks[17], (DEPTH, D_DIFF), 0.1),
        'lambda_k2': nrm(ks[18], (DEPTH, D_DIFF), 0.1),
        'diff_norm': gain(ks[19], (DEPTH, 2 * D_DIFF)),
        'w_out': nrm(ks[20], (DEPTH, MIX_W, D_MODEL), MIX_W ** -0.5),
        'ln_mem_q': gain(ks[21], (DEPTH, D_MODEL)),
        'ln_mem_kv': gain(ks[22], (DEPTH, D_MODEL)),
        'w_mem_q': nrm(ks[23], (DEPTH, D_MODEL, D_MODEL), D_MODEL ** -0.5),
        'w_mem_k': nrm(ks[24], (DEPTH, D_MODEL, D_MODEL), D_MODEL ** -0.5),
        'w_mem_v': nrm(ks[25], (DEPTH, D_MODEL, D_MODEL), D_MODEL ** -0.5),
        'w_mem_o': nrm(ks[26], (DEPTH, D_MODEL, D_MODEL), D_MODEL ** -0.5),
        'ln_ffn': gain(ks[27], (DEPTH, D_MODEL)),
        'w_ff1': nrm(ks[28], (DEPTH, D_MODEL, D_FF), D_MODEL ** -0.5),
        'w_ff2': nrm(ks[29], (DEPTH, D_FF, D_MODEL), D_FF ** -0.5),
        'ln_final': gain(ks[30], (D_MODEL,)),
    }


def reference(x_prompt, x_sample, mem_prompt, cache_diff_k, cache_diff_v, cache_mem_k, cache_mem_v,
              state_gdn, state_gdn_conv, ln_mix, w_in, conv_w, a_log, dt_bias, gdn_norm,
              lambda_q1, lambda_k1, lambda_q2, lambda_k2, diff_norm, w_out, ln_mem_q, ln_mem_kv,
              w_mem_q, w_mem_k, w_mem_v, w_mem_o, ln_ffn, w_ff1, w_ff2, ln_final):
    Bp = x_prompt.shape[0]
    hp, hs = x_prompt, x_sample
    pk, pv, pS, pc, pmk, pmv = [], [], [], [], [], []
    sk, sv, sS, sc = [], [], [], []
    for l in range(DEPTH):
        p = dict(ln_mix=ln_mix[l], w_in=w_in[l], conv_w=conv_w[l], a_log=a_log[l], dt_bias=dt_bias[l],
                 gdn_norm=gdn_norm[l], lq1=lambda_q1[l], lk1=lambda_k1[l], lq2=lambda_q2[l], lk2=lambda_k2[l],
                 diff_norm=diff_norm[l], w_out=w_out[l], ln_mem_q=ln_mem_q[l], w_mem_q=w_mem_q[l],
                 w_mem_o=w_mem_o[l], ln_ffn=ln_ffn[l], w_ff1=w_ff1[l], w_ff2=w_ff2[l])
        lam_init = 0.8 - 0.6 * math.exp(-0.3 * l)
        mk, mv = _mem_kv(mem_prompt, ln_mem_kv[l], w_mem_k[l], w_mem_v[l])
        S0 = jnp.zeros((Bp, H_GDN, DK_GDN, DV_GDN), jnp.float32)
        buf0 = jnp.zeros((Bp, CONV_W - 1, CONV_CH), x_prompt.dtype)
        hp, kp_, vp_, Sp_, cp_ = _layer(hp, mk, mv, None, None, S0, buf0, lam_init, p)
        pk.append(kp_); pv.append(vp_); pS.append(Sp_); pc.append(cp_); pmk.append(mk); pmv.append(mv)
        hs, ks_, vs_, Ss_, cs_ = _layer(hs, cache_mem_k[l], cache_mem_v[l], cache_diff_k[l], cache_diff_v[l],
                                        state_gdn[l], state_gdn_conv[l], lam_init, p)
        sk.append(ks_); sv.append(vs_); sS.append(Ss_); sc.append(cs_)
    y_prompt = _rmsnorm(hp, ln_final)
    y_sample = _rmsnorm(hs, ln_final)
    return (y_prompt, y_sample,
            jnp.stack(pk), jnp.stack(pv), jnp.stack(pS), jnp.stack(pc), jnp.stack(pmk), jnp.stack(pmv),
            jnp.stack(sk), jnp.stack(sv), jnp.stack(sS), jnp.stack(sc))
```

```cpp
#include <hip/hip_runtime.h>
#include <hip/hip_cooperative_groups.h>
#include <cstdio>
namespace cg = cooperative_groups;
__device__ __forceinline__ int opaque_tid() { int t = threadIdx.x; asm volatile("" : "+v"(t)); return t; }
namespace pg8 {
#define PG8_LAS __attribute__((address_space(3)))
typedef unsigned short bf16_t;
typedef short bf16x8 __attribute__((ext_vector_type(8)));
typedef float f32x4 __attribute__((ext_vector_type(4)));
typedef unsigned u32x4 __attribute__((ext_vector_type(4)));
constexpr int BM = 256, BK = 64, HALF = 128, HTB = HALF * BK * 2  , STAGE_BYTES = 8 * HTB, NXCD = 8, WGM = 8;

__host__ __device__ __forceinline__ int lds_byte(int r, int c) { const int st = (r >> 4) * 2 + (c >> 5), rr = r & 15, cc = c & 31, ob = rr * 64 + cc * 2; return st * 1024 + (ob ^ (((ob >> 9) & 1) << 5)); }
__host__ __device__ __forceinline__ void stage_rc(int b, int& R, int& C) { const int st = b / 1024, sb = b % 1024, swz = sb ^ (((sb >> 9) & 1) << 5); R = (st >> 1) * 16 + swz / 64; C = (st & 1) * 32 + (swz % 64) / 2; }
__host__ __device__ __forceinline__ int perm32(int rho) { const int n = rho >> 4, i = rho & 15; return 8 * (i >> 2) + 4 * n + (i & 3); }

struct Unit { int pm, pn; };
struct Gemm { const bf16_t* A; const bf16_t* Bt; int M, N, K; };

struct StaticOrder {
    int nM, nN, nwg, G, c;
    __host__ __device__ void init(int M, int N, int G_, int c_) { nM = M / BM; nN = N / BM; nwg = nM * nN; G = G_; c = c_; }
    __host__ __device__ bool next(int i, Unit& u) const {
        const long L = (long)i * G + c; if (L >= nwg) return false;
        int wgid = (int)L; { const int q = nwg / NXCD, r = nwg % NXCD, xcd = wgid % NXCD, off = wgid / NXCD; wgid = (xcd < r ? xcd * (q + 1) : r * (q + 1) + (xcd - r) * q) + off; }
        const int nig = WGM * nN, gid = wgid / nig, fm = gid * WGM, gsz = (nM - fm) < WGM ? (nM - fm) : WGM;
        u.pm = fm + ((wgid % nig) % gsz); u.pn = (wgid % nig) / gsz; return true;
    }
    __device__ __forceinline__ void a_ready(const Unit&) const {}
    __device__ __forceinline__ void done(const Unit&) const {}
};

__device__ __forceinline__ unsigned cvt_pk_bf16(float lo, float hi) { unsigned r; asm volatile("v_cvt_pk_bf16_f32 %0, %1, %2" : "=v"(r) : "v"(lo), "v"(hi)); return r; }
typedef float f32x2 __attribute__((ext_vector_type(2)));
template <class Epi, class Sched, bool ALIGN_EPI = false, bool SP2 = false>
__device__ __forceinline__ void gemm_phase(PG8_LAS unsigned char* lds, const Gemm g, const Sched& S, const Epi& E) {
    const int tid = opaque_tid(), wid = __builtin_amdgcn_readfirstlane(tid >> 6), lane = tid & 63, wr = wid >> 2, wc = wid & 3, fr = lane & 15, fq = lane >> 4;
    const int K = g.K, nt = K / BK;
    unsigned voffA[2], voffB[2];
#pragma unroll
    for (int i = 0; i < 2; ++i) { int R, C; stage_rc(tid * 16 + i * 8192, R, C); const int Rb = Epi::PERM ? ((R & ~31) + perm32(R & 31)) : R;
        voffA[i] = (unsigned)(R * K + C) * 2u; voffB[i] = (unsigned)(Rb * K + C) * 2u; }
    const size_t kstep = (size_t)(BK * 2);
    const size_t hstep = (size_t)HALF * K * 2;
    const size_t tstep = 2 * hstep;
    const unsigned ldsw = (unsigned)wid * 1024u;
    const int aoff = lds_byte(wr * 64 + fr, fq * 8), boff = lds_byte(wc * 32 + fr, fq * 8);
#define PG8_SA(b, h) (((b) * 2 + (h)) * HTB)
#define PG8_SB(b, h) ((4 + (b) * 2 + (h)) * HTB)
#define PG8_STAGE(bufoff, gbase, voff) do { _Pragma("unroll") for (int _i = 0; _i < 2; ++_i) \
        __builtin_amdgcn_global_load_lds((const unsigned*)((const char*)(gbase) + (voff)[_i]), (PG8_LAS unsigned*)(lds + (bufoff) + ldsw + _i * 8192), 16, 0, 0); } while (0)
#define PG8_LDA(dst, b, h) do { _Pragma("unroll") for (int m = 0; m < 4; ++m) _Pragma("unroll") for (int k = 0; k < 2; ++k) dst[m][k] = *(const PG8_LAS bf16x8*)(lds + PG8_SA(b, h) + aoff + m * 2048 + k * 1024); } while (0)
#define PG8_LDB(dst, b, h) do { _Pragma("unroll") for (int n = 0; n < 2; ++n) _Pragma("unroll") for (int k = 0; k < 2; ++k) dst[n][k] = *(const PG8_LAS bf16x8*)(lds + PG8_SB(b, h) + boff + n * 2048 + k * 1024); } while (0)
#define PG8_MMA(ai, bj, At, Bt) do { __builtin_amdgcn_s_setprio(1); _Pragma("unroll") for (int m = 0; m < 4; ++m) _Pragma("unroll") for (int n = 0; n < 2; ++n) _Pragma("unroll") for (int k = 0; k < 2; ++k) \
        acc[ai][bj][m][n] = __builtin_amdgcn_mfma_f32_16x16x32_bf16(Bt[n][k], At[m][k], acc[ai][bj][m][n], 0, 0, 0); __builtin_amdgcn_s_setprio(0); } while (0)
#define PG8_WAIT_V(n) asm volatile("s_waitcnt vmcnt(" #n ")" ::: "memory")
#define PG8_WAIT_L(n) asm volatile("s_waitcnt lgkmcnt(" #n ")" ::: "memory")
#define PG8_BAR __builtin_amdgcn_s_barrier()
#define PG8_SCHED __builtin_amdgcn_sched_barrier(0)
    Unit cur, nxt; int ui = 0;
    if (!S.next(0, cur)) return;
    f32x4 acc[2][2][4][2];
#pragma unroll
    for (int a = 0; a < 2; ++a)
#pragma unroll
        for (int b = 0; b < 2; ++b)
#pragma unroll
            for (int m = 0; m < 4; ++m)
#pragma unroll
                for (int n = 0; n < 2; ++n) acc[a][b][m][n] = (f32x4){0.f, 0.f, 0.f, 0.f};
    bf16x8 At[4][2], B0[2][2], B1[2][2];
    const char* cA = (const char*)g.A + (size_t)cur.pm * tstep; const char* cB = (const char*)g.Bt + (size_t)cur.pn * tstep;
    S.a_ready(cur);
    if constexpr (SP2) {
        PG8_STAGE(PG8_SB(0, 0), cB, voffB); PG8_STAGE(PG8_SB(0, 1), cB + hstep, voffB); PG8_STAGE(PG8_SA(0, 0), cA, voffA); PG8_STAGE(PG8_SA(0, 1), cA + hstep, voffA);
        if (wr == 1) PG8_BAR;
        PG8_WAIT_V(2); PG8_BAR;
        PG8_STAGE(PG8_SB(1, 0), cB + kstep, voffB); PG8_STAGE(PG8_SA(1, 0), cA + kstep, voffA); PG8_STAGE(PG8_SB(1, 1), cB + hstep + kstep, voffB);
        PG8_WAIT_V(6); PG8_BAR;
    } else {
        PG8_STAGE(PG8_SB(0, 0), cB, voffB); PG8_STAGE(PG8_SA(0, 0), cA, voffA); PG8_STAGE(PG8_SB(0, 1), cB + hstep, voffB); PG8_STAGE(PG8_SA(0, 1), cA + hstep, voffA);
        if (wr == 1) PG8_BAR;
        PG8_WAIT_V(4); PG8_BAR;
        PG8_STAGE(PG8_SB(1, 0), cB + kstep, voffB); PG8_STAGE(PG8_SA(1, 0), cA + kstep, voffA); PG8_STAGE(PG8_SB(1, 1), cB + hstep + kstep, voffB);
        PG8_WAIT_V(6); PG8_BAR;
    }
    for (;;) {
        const bool has_next = S.next(ui + 1, nxt);
        const char* nA = has_next ? (const char*)g.A + (size_t)nxt.pm * tstep : cA; const char* nB = has_next ? (const char*)g.Bt + (size_t)nxt.pn * tstep : cB;
        for (int t = 0; t < nt; t += 2) {
            const bool last = (t == nt - 2);
            const char* a1 = cA + (size_t)(t + 1) * kstep;
            const char* a2 = last ? nA : cA + (size_t)(t + 2) * kstep; const char* b2 = last ? nB : cB + (size_t)(t + 2) * kstep;
            const char* a3 = a2 + kstep; const char* b3 = b2 + kstep;
            if (last && has_next) S.a_ready(nxt);
            if constexpr (SP2) {
            PG8_LDB(B0, 0, 0); PG8_LDB(B1, 0, 1); PG8_SCHED; PG8_LDA(At, 0, 0); PG8_STAGE(PG8_SA(1, 1), a1 + hstep, voffA);
            PG8_WAIT_V(8); PG8_WAIT_L(0); PG8_BAR; PG8_MMA(0, 0, At, B0); PG8_MMA(0, 1, At, B1); PG8_BAR; PG8_SCHED;
            PG8_LDA(At, 0, 1); PG8_STAGE(PG8_SB(0, 0), b2, voffB); PG8_STAGE(PG8_SB(0, 1), b2 + hstep, voffB); PG8_STAGE(PG8_SA(0, 0), a2, voffA);
            PG8_WAIT_V(8); PG8_WAIT_L(0); PG8_BAR; PG8_MMA(1, 0, At, B0); PG8_MMA(1, 1, At, B1); PG8_BAR; PG8_SCHED;
            PG8_LDB(B0, 1, 0); PG8_LDB(B1, 1, 1); PG8_SCHED; PG8_LDA(At, 1, 0); PG8_STAGE(PG8_SA(0, 1), a2 + hstep, voffA);
            PG8_WAIT_V(8); PG8_WAIT_L(0); PG8_BAR; PG8_MMA(0, 0, At, B0); PG8_MMA(0, 1, At, B1); PG8_BAR; PG8_SCHED;
            PG8_LDA(At, 1, 1); PG8_STAGE(PG8_SB(1, 0), b3, voffB); PG8_STAGE(PG8_SB(1, 1), b3 + hstep, voffB); PG8_STAGE(PG8_SA(1, 0), a3, voffA);
            PG8_WAIT_V(8); PG8_WAIT_L(0); PG8_BAR; PG8_MMA(1, 0, At, B0); PG8_MMA(1, 1, At, B1); PG8_BAR; PG8_SCHED;
            } else {
            PG8_LDB(B0, 0, 0); PG8_SCHED; PG8_LDA(At, 0, 0); PG8_STAGE(PG8_SA(1, 1), a1 + hstep, voffA);
            PG8_WAIT_L(8); PG8_BAR; PG8_WAIT_L(0); PG8_MMA(0, 0, At, B0); PG8_BAR; PG8_SCHED;
            PG8_LDB(B1, 0, 1); PG8_STAGE(PG8_SB(0, 0), b2, voffB);
            PG8_BAR; PG8_WAIT_L(0); PG8_MMA(0, 1, At, B1); PG8_BAR;
            PG8_LDA(At, 0, 1); PG8_STAGE(PG8_SA(0, 0), a2, voffA);
            PG8_BAR; PG8_WAIT_L(0); PG8_MMA(1, 0, At, B0); PG8_BAR; PG8_SCHED;
            PG8_STAGE(PG8_SB(0, 1), b2 + hstep, voffB);
            PG8_WAIT_V(6); PG8_BAR; PG8_MMA(1, 1, At, B1); PG8_BAR;
            PG8_LDB(B0, 1, 0); PG8_SCHED; PG8_LDA(At, 1, 0); PG8_STAGE(PG8_SA(0, 1), a2 + hstep, voffA);
            PG8_WAIT_L(8); PG8_BAR; PG8_WAIT_L(0); PG8_MMA(0, 0, At, B0); PG8_BAR; PG8_SCHED;
            PG8_LDB(B1, 1, 1); PG8_STAGE(PG8_SB(1, 0), b3, voffB);
            PG8_BAR; PG8_WAIT_L(0); PG8_MMA(0, 1, At, B1); PG8_BAR;
            PG8_LDA(At, 1, 1); PG8_STAGE(PG8_SA(1, 0), a3, voffA);
            PG8_BAR; PG8_WAIT_L(0); PG8_MMA(1, 0, At, B0); PG8_BAR; PG8_SCHED;
            PG8_STAGE(PG8_SB(1, 1), b3 + hstep, voffB);
            PG8_WAIT_V(6); PG8_BAR; PG8_MMA(1, 1, At, B1); PG8_BAR;
            }
        }
        if constexpr (ALIGN_EPI) { if (wr == 0) PG8_BAR; }
        if constexpr (!Epi::AFTER_DRAIN) { E(acc, cur, wr, wc, fr, fq); S.done(cur); }
        if (!has_next) break;
#pragma unroll
        for (int a = 0; a < 2; ++a)
#pragma unroll
            for (int b = 0; b < 2; ++b)
#pragma unroll
                for (int m = 0; m < 4; ++m)
#pragma unroll
                    for (int n = 0; n < 2; ++n) acc[a][b][m][n] = (f32x4){0.f, 0.f, 0.f, 0.f};
        cur = nxt; cA = nA; cB = nB; ++ui;
        if constexpr (ALIGN_EPI) { if (wr == 1) PG8_BAR; }
    }
    PG8_WAIT_V(0);
    if constexpr (!ALIGN_EPI) { if (wr == 0) PG8_BAR; }
    PG8_BAR;
    if constexpr (Epi::AFTER_DRAIN) { E.fused(acc, cur, wr, wc, fr, fq, lds, wid, lane); S.done(cur); }
#undef PG8_SA
#undef PG8_SB
#undef PG8_STAGE
#undef PG8_LDA
#undef PG8_LDB
#undef PG8_MMA
#undef PG8_WAIT_V
#undef PG8_WAIT_L
#undef PG8_BAR
#undef PG8_SCHED
}
}

#define LAS __attribute__((address_space(3)))
typedef unsigned short bf16;
using pg8::bf16x8; using pg8::f32x4; using pg8::u32x4;
typedef unsigned u32x2 __attribute__((ext_vector_type(2)));
typedef float f32x2v __attribute__((ext_vector_type(2)));
constexpr int TP = 65536, TS = 512, TT = TP + TS;
constexpr int DM = 1024, NL = 4, NIN = 3584, DFF = 4096;
constexpr float EPS = 1e-6f;
constexpr int NITEM = 4128;
constexpr size_t O_Y = 0, O_KP = (size_t)TT * DM, O_VP = O_KP + (size_t)NL * TP * 512, O_GP = O_VP + (size_t)NL * TP * 512, O_CP = O_GP + (size_t)NL * 16 * 4 * 16384,
    O_MKP = O_CP + (size_t)NL * 16 * 3 * 1536, O_MVP = O_MKP + (size_t)NL * 4096 * 1024, O_KS = O_MVP + (size_t)NL * 4096 * 1024, O_VS = O_KS + (size_t)NL * TS * 512,
    O_GS = O_VS + (size_t)NL * TS * 512, O_CS = O_GS + (size_t)NL * 8 * 4 * 16384, O_END = O_CS + (size_t)NL * 8 * 3 * 1536;
static_assert(O_END == 378454016ull, "output size");
constexpr size_t al(size_t x) { return (x + 4095) & ~(size_t)4095; }
constexpr size_t W_WIN = 0, W_WOUT = al(W_WIN + (size_t)NL * NIN * DM * 2), W_WQ = al(W_WOUT + (size_t)NL * DM * DM * 2), W_WO = al(W_WQ + (size_t)NL * DM * DM * 2),
    W_WKV = al(W_WO + (size_t)NL * DM * DM * 2), W_W1 = al(W_WKV + (size_t)NL * 2048 * DM * 2), W_W2 = al(W_W1 + (size_t)NL * DFF * DM * 2), W_WAB = al(W_W2 + (size_t)NL * DFF * DM * 2),
    W_HB = al(W_WAB + (size_t)NL * 8 * DM * 4), W_SSQ = al(W_HB + (size_t)TT * DM * 2), W_PROJ = al(W_SSQ + (size_t)TT * 16 * 4), W_PVT = al(W_PROJ + (size_t)6 * TT * 512 * 2),
    W_SVT = al(W_PVT + (size_t)64 * 128 * 4096 * 2), W_SK = al(W_SVT + (size_t)NL * 32 * 128 * 2112 * 2), W_UT = al(W_SK + (size_t)NL * 8 * 2112 * 512 * 2),
    W_WM = al(W_UT + (size_t)NITEM * 8192 * 2), W_QG = al(W_WM + (size_t)NITEM * 8192 * 2), W_KDT = al(W_QG + (size_t)NITEM * 8192 * 2), W_QK = al(W_KDT + (size_t)NITEM * 8192 * 2),
    W_GL = al(W_QK + (size_t)NITEM * 4096 * 2), W_MIX = al(W_GL + (size_t)NITEM * 4), W_QM = al(W_MIX + (size_t)TT * DM * 2), W_MA = al(W_QM + (size_t)TT * DM * 2),
    W_FH = al(W_MA + (size_t)TT * DM * 2), W_MEMB = al(W_FH + (size_t)TT * DFF * 2), W_RINVM = al(W_MEMB + (size_t)4096 * DM * 2), W_MKB = al(W_RINVM + 4096 * 4),
    W_MVT = al(W_MKB + (size_t)NL * 4096 * DM * 2), W_CMK = al(W_MVT + (size_t)NL * 4096 * DM * 2), W_CMVT = al(W_CMK + (size_t)NL * 2048 * DM * 2), W_CTL = al(W_CMVT + (size_t)NL * 2048 * DM * 2), W_END = W_CTL + 32768;
constexpr size_t CTL_BYTES = 32768;
constexpr int LDS_BYTES = 147456;

struct Params { const float* in[31]; float* out; unsigned char* ws; };
constexpr int LDS_PARAMS = LDS_BYTES - 512;
struct LP { volatile __attribute__((address_space(3))) const unsigned* base;
    __device__ __forceinline__ unsigned long long raw(int i) const { unsigned off = 8u * (unsigned)i; asm volatile("" : "+v"(off));
        volatile __attribute__((address_space(3))) const unsigned* q = (volatile __attribute__((address_space(3))) const unsigned*)((volatile __attribute__((address_space(3))) const unsigned char*)base + off);
        unsigned lo = q[0], hi = q[1]; lo = __builtin_amdgcn_readfirstlane(lo); hi = __builtin_amdgcn_readfirstlane(hi); return ((unsigned long long)hi << 32) | lo; }
    __device__ __forceinline__ const float* in(int i) const { return (const float*)(const __attribute__((address_space(1))) float*)raw(i); }
    __device__ __forceinline__ float* out() const { return (float*)(__attribute__((address_space(1))) float*)raw(31); }
    __device__ __forceinline__ unsigned char* ws() const { return (unsigned char*)(__attribute__((address_space(1))) unsigned char*)raw(32); } };
enum { I_XP = 0, I_XS, I_MEM, I_CDK, I_CDV, I_CMK, I_CMV, I_SG, I_SGC, I_LNMIX, I_WIN, I_CONVW, I_ALOG, I_DTB, I_GNORM, I_LQ1, I_LK1, I_LQ2, I_LK2, I_DNORM, I_WOUT, I_LNMQ, I_LNMKV,
       I_WMQ, I_WMK, I_WMV, I_WMO, I_LNFFN, I_W1, I_W2, I_LNF };

__device__ __forceinline__ float bf2f(unsigned b) { return __uint_as_float(b << 16); }
typedef float f32x2_t __attribute__((ext_vector_type(2)));
typedef __bf16 bf16x2_t __attribute__((ext_vector_type(2)));
__device__ __forceinline__ unsigned pk2(float lo, float hi) { f32x2_t v = {lo, hi}; bf16x2_t b = __builtin_convertvector(v, bf16x2_t); return __builtin_bit_cast(unsigned, b); }
__device__ __forceinline__ bf16 f2bf(float f) { return (bf16)(pk2(f, 0.f) & 0xffffu); }
template <int CTRL, int ROWMASK> __device__ __forceinline__ float dppf(float oldv, float v) {
    return __builtin_bit_cast(float, __builtin_amdgcn_update_dpp(__builtin_bit_cast(int, oldv), __builtin_bit_cast(int, v), CTRL, ROWMASK, 0xf, false)); }
__device__ __forceinline__ float wave_sum(float v) {
    v += dppf<0xb1, 0xf>(v, v);
    v += dppf<0x4e, 0xf>(v, v);
    v += dppf<0x124, 0xf>(v, v);
    v += dppf<0x128, 0xf>(v, v);
    v += dppf<0x142, 0xa>(0.f, v);
    v += dppf<0x143, 0xc>(0.f, v);
    return __builtin_bit_cast(float, __builtin_amdgcn_readlane(__builtin_bit_cast(int, v), 63));
}
__device__ __forceinline__ f32x4 mfma16(bf16x8 a, bf16x8 b, f32x4 c) { return __builtin_amdgcn_mfma_f32_16x16x32_bf16(a, b, c, 0, 0, 0); }
__device__ __forceinline__ bf16x8 lfrag(const LAS unsigned char* base, int row, int stride, int col) { return *(const LAS bf16x8*)(base + row * stride + col * 2); }
__device__ __forceinline__ bf16x8 gfrag(const bf16* p) { return *(const bf16x8*)p; }
#define LDS_WAIT() asm volatile("s_waitcnt lgkmcnt(0)" ::: "memory")

__device__ __forceinline__ void rinv8(const float* ssq, int row0, int fq, float (&ri)[2][4]) {
#pragma unroll
    for (int ai = 0; ai < 2; ++ai)
#pragma unroll
        for (int m = 0; m < 4; ++m) { const int r = row0 + ai * 128 + m * 16; const f32x4 v = *(const f32x4*)(ssq + (size_t)r * 16 + 4 * fq);
            float s = (v[0] + v[1]) + (v[2] + v[3]); s += __shfl_xor(s, 16); s += __shfl_xor(s, 32); ri[ai][m] = rsqrtf(s * (1.0f / 1024.0f) + EPS); }
}
__device__ __forceinline__ float rinv1(const float* ssq, int r, int fq) {
    const f32x4 v = *(const f32x4*)(ssq + (size_t)r * 16 + 4 * fq); float s = (v[0] + v[1]) + (v[2] + v[3]); s += __shfl_xor(s, 16); s += __shfl_xor(s, 32); return rsqrtf(s * (1.0f / 1024.0f) + EPS); }
#define EPI_FENCE() do { } while (0)
__device__ __forceinline__ u32x4 pack8(const f32x4 a, const f32x4 b) { u32x4 w; w.x = pk2(a[0], a[1]); w.y = pk2(a[2], a[3]); w.z = pk2(b[0], b[1]); w.w = pk2(b[2], b[3]); return w; }

struct EpiIn {
    static constexpr bool PERM = true, AFTER_DRAIN = false;
    const float* ssq; bf16* proj; bf16* pvt; bf16* svt_l; bf16* sk_l; float* okp_l; float* ovp_l; float* oks_l; float* ovs_l;
    __device__ __forceinline__ void operator()(const f32x4 (&acc)[2][2][4][2], const pg8::Unit& u, int wr, int wc, int fr, int fq) const {
        const int row0 = u.pm * 256 + wr * 64 + fr; float ri[2][4]; rinv8(ssq, row0, fq, ri);
        const int tsr = u.pn >> 1, colt0 = (u.pn & 1) * 256 + wc * 32 + 8 * fq; const bool prompt = u.pm < 256;
#pragma unroll
        for (int ai = 0; ai < 2; ++ai)
#pragma unroll
            for (int m = 0; m < 4; ++m) { const int r = row0 + ai * 128 + m * 16; const float sc = ri[ai][m];
#pragma unroll
                for (int bj = 0; bj < 2; ++bj) { const int c = colt0 + bj * 128; const f32x4 v0 = acc[ai][bj][m][0] * sc, v1 = acc[ai][bj][m][1] * sc;
                    if (tsr < 6) *(u32x4*)(proj + (size_t)tsr * TT * 512 + (size_t)r * 512 + c) = pack8(v0, v1);
                    if (tsr >= 5) { float* dst = prompt ? ((tsr == 5 ? okp_l : ovp_l) + (size_t)r * 512 + c) : ((tsr == 5 ? oks_l : ovs_l) + (size_t)(r - TP) * 512 + c);
                        *(f32x4*)dst = v0; *(f32x4*)(dst + 4) = v1; }
                    if (tsr == 5 && !prompt) { const int rs = r - TP, b = rs >> 6, t = rs & 63; *(u32x4*)(sk_l + ((size_t)b * 2112 + 2048 + t) * 512 + c) = pack8(v0, v1); }
                    if (tsr == 6) { const int hh = c >> 7, e0 = c & 127; bf16* base; size_t st;
                        if (prompt) { const int b = r >> 12, t = r & 4095; base = pvt + ((size_t)(b * 4 + hh) * 128 + e0) * 4096 + t; st = 4096; }
                        else { const int rs = r - TP, b = rs >> 6, t = rs & 63; base = svt_l + ((size_t)(b * 4 + hh) * 128 + e0) * 2112 + 2048 + t; st = 2112; }
#pragma unroll
                        for (int j = 0; j < 4; ++j) { base[(size_t)j * st] = f2bf(v0[j]); base[(size_t)(j + 4) * st] = f2bf(v1[j]); } }
                } EPI_FENCE(); }
    }
};
struct EpiRes {
    static constexpr bool PERM = true, AFTER_DRAIN = false;
    float* H; bf16* hb; float* ssq;
    __device__ __forceinline__ void operator()(const f32x4 (&acc)[2][2][4][2], const pg8::Unit& u, int wr, int wc, int fr, int fq) const {
        const int row0 = u.pm * 256 + wr * 64 + fr, col0 = u.pn * 256 + wc * 32 + 8 * fq;
#pragma unroll
        for (int ai = 0; ai < 2; ++ai)
#pragma unroll
            for (int m = 0; m < 4; ++m) { const int r = row0 + ai * 128 + m * 16; float ss = 0.f;
#pragma unroll
                for (int bj = 0; bj < 2; ++bj) { bf16* hp = hb + (size_t)r * DM + col0 + bj * 128; const u32x4 hv = *(const u32x4*)hp;
                    f32x4 v0, v1; v0[0] = bf2f(hv.x & 0xffffu); v0[1] = bf2f(hv.x >> 16); v0[2] = bf2f(hv.y & 0xffffu); v0[3] = bf2f(hv.y >> 16); v1[0] = bf2f(hv.z & 0xffffu); v1[1] = bf2f(hv.z >> 16); v1[2] = bf2f(hv.w & 0xffffu); v1[3] = bf2f(hv.w >> 16);
                    v0 += acc[ai][bj][m][0]; v1 += acc[ai][bj][m][1];
                    *(u32x4*)hp = pack8(v0, v1);
                    ss += (v0[0] * v0[0] + v0[1] * v0[1]) + (v0[2] * v0[2] + v0[3] * v0[3]) + (v1[0] * v1[0] + v1[1] * v1[1]) + (v1[2] * v1[2] + v1[3] * v1[3]); }
                ss += __shfl_xor(ss, 16); ss += __shfl_xor(ss, 32);
                if (fq == 0) ssq[(size_t)r * 16 + u.pn * 4 + wc] = ss; EPI_FENCE(); }
    }
};
template <int ACT> struct EpiRow {
    static constexpr bool PERM = true, AFTER_DRAIN = false;
    const float* ssq; bf16* O; int ldc;
    __device__ __forceinline__ void operator()(const f32x4 (&acc)[2][2][4][2], const pg8::Unit& u, int wr, int wc, int fr, int fq) const {
        const int row0 = u.pm * 256 + wr * 64 + fr, col0 = u.pn * 256 + wc * 32 + 8 * fq; float ri[2][4]; rinv8(ssq, row0, fq, ri);
#pragma unroll
        for (int ai = 0; ai < 2; ++ai)
#pragma unroll
            for (int m = 0; m < 4; ++m) { const int r = row0 + ai * 128 + m * 16; const float sc = ri[ai][m];
#pragma unroll
                for (int bj = 0; bj < 2; ++bj) { f32x4 v0 = acc[ai][bj][m][0] * sc, v1 = acc[ai][bj][m][1] * sc;
                    if (ACT == 1) {
#pragma unroll
                        for (int j = 0; j < 4; ++j) { const float a = fmaxf(v0[j], 0.f), b = fmaxf(v1[j], 0.f); v0[j] = a * a; v1[j] = b * b; } }
                    *(u32x4*)(O + (size_t)r * ldc + col0 + bj * 128) = pack8(v0, v1); } EPI_FENCE(); }
    }
};
struct EpiMemKV {
    static constexpr bool PERM = true, AFTER_DRAIN = false;
    const float* rinvm; float* omk; float* omv; bf16* mkb; bf16* mvt;
    __device__ __forceinline__ void operator()(const f32x4 (&acc)[2][2][4][2], const pg8::Unit& u, int wr, int wc, int fr, int fq) const {
        const int row0 = u.pm * 256 + wr * 64 + fr, l = u.pn >> 3, kv = (u.pn >> 2) & 1, col0 = (u.pn & 3) * 256 + wc * 32 + 8 * fq;
#pragma unroll
        for (int ai = 0; ai < 2; ++ai)
#pragma unroll
            for (int m = 0; m < 4; ++m) { const int r = row0 + ai * 128 + m * 16; const float sc = rinvm[r];
#pragma unroll
                for (int bj = 0; bj < 2; ++bj) { const int c = col0 + bj * 128; const f32x4 v0 = acc[ai][bj][m][0] * sc, v1 = acc[ai][bj][m][1] * sc;
                    float* dst = (kv ? omv : omk) + ((size_t)l * 4096 + r) * 1024 + c; *(f32x4*)dst = v0; *(f32x4*)(dst + 4) = v1;
                    if (!kv) *(u32x4*)(mkb + ((size_t)l * 4096 + r) * 1024 + c) = pack8(v0, v1);
                    else { const int hh = c >> 8, e0 = c & 255, b = r >> 8, mm = r & 255; bf16* base = mvt + ((((size_t)l * 16 + b) * 4 + hh) * 256 + e0) * 256 + mm;
#pragma unroll
                        for (int j = 0; j < 4; ++j) { base[(size_t)j * 256] = f2bf(v0[j]); base[(size_t)(j + 4) * 256] = f2bf(v1[j]); } } } EPI_FENCE(); }
    }
};
#define XB_TMO      128
#define XB_XCNT(j)  (256  + 64 * (j))
#define XB_XSUB(j)  (1280 + 64 * (j))
#define XB_XGEN(j)  (2304 + 64 * (j))
#define XB_TOP      3328
#define XB_TOPGEN   3392
#define XCD_BAR_WORDS 3456
#define XB_SPIN_CAP (1u << 18)

__device__ __forceinline__ unsigned xb_ld(unsigned* p)              { return __hip_atomic_load(p, __ATOMIC_RELAXED, __HIP_MEMORY_SCOPE_AGENT); }
__device__ __forceinline__ unsigned xb_add(unsigned* p, unsigned v) { return __hip_atomic_fetch_add(p, v, __ATOMIC_RELAXED, __HIP_MEMORY_SCOPE_AGENT); }
__device__ __forceinline__ unsigned xb_xcc_id() { return (unsigned)__builtin_amdgcn_s_getreg((3 << 11) | 20) & 0xFu; }
#define XB_SPIN(cond, bar) do { unsigned _sp = 0; while (cond) { __builtin_amdgcn_s_sleep(1); \
    if ((++_sp & 255u) == 0u) { if (xb_ld(&(bar)[XB_TMO])) break; if (_sp > XB_SPIN_CAP) { atomicAdd(&(bar)[XB_TMO], 1u); break; } } } } while (0)

struct XcdBarrier {
    unsigned* bar; unsigned x;
    volatile LAS unsigned* st;
};

__device__ __forceinline__ XcdBarrier xcd_barrier_post(unsigned* bar, volatile LAS unsigned* st) {
    XcdBarrier b; b.bar = bar; b.x = xb_xcc_id(); b.st = st;
    if (threadIdx.x == 0) (void)xb_add(&bar[XB_XCNT(b.x)], 1u);
    return b;
}
__device__ __forceinline__ void xcd_barrier_complete(unsigned* bar, unsigned x, unsigned& nloc, unsigned& nx) {
    const unsigned G = gridDim.x * gridDim.y * gridDim.z;
    unsigned sum, cnt, mine, sp = 0u;
    for (;;) {
        sum = 0u; cnt = 0u; mine = 0u;
#pragma unroll
        for (unsigned j = 0; j < 16; ++j) { const unsigned c = xb_ld(&bar[XB_XCNT(j)]); sum += c; cnt += (c > 0u) ? 1u : 0u; mine = (j == x) ? c : mine; }
        if (sum == G) break;
        __builtin_amdgcn_s_sleep(1);
        if ((++sp & 255u) == 0u) { if (xb_ld(&bar[XB_TMO])) break; if (sp > XB_SPIN_CAP) { atomicAdd(&bar[XB_TMO], 1u); break; } }
    }
    nloc = mine > 0u ? mine : 1u; nx = cnt > 0u ? cnt : 1u;
}

__device__ __forceinline__ void xcd_barrier(const XcdBarrier& b) {
    asm volatile("s_waitcnt vmcnt(0)" ::: "memory");
    __syncthreads();
    if (threadIdx.x == 0) {
        unsigned* bar = b.bar;
        __builtin_amdgcn_s_waitcnt(0);
        unsigned nloc = b.st[0], nx = b.st[1];
        if (nloc == 0u) { xcd_barrier_complete(bar, b.x, nloc, nx); b.st[0] = nloc; b.st[1] = nx; }
        const unsigned old = xb_add(&bar[XB_XSUB(b.x)], 1u);
        const unsigned gen = old / nloc;
        if (old + 1u == (gen + 1u) * nloc) {
            __builtin_amdgcn_fence(__ATOMIC_RELEASE, "agent");
            asm volatile("s_waitcnt vmcnt(0)" ::: "memory");
            const unsigned og = xb_add(&bar[XB_TOP], 1u);
            const unsigned tg = og / nx;
            if (og + 1u == (tg + 1u) * nx) xb_add(&bar[XB_TOPGEN], 1u);
            else XB_SPIN(xb_ld(&bar[XB_TOPGEN]) == tg, bar);
            __builtin_amdgcn_fence(__ATOMIC_ACQUIRE, "agent");
            xb_add(&bar[XB_XGEN(b.x)], 1u);
            asm volatile("s_waitcnt vmcnt(0)" ::: "memory");
        } else {
            XB_SPIN(xb_ld(&bar[XB_XGEN(b.x)]) == gen, bar);
            __builtin_amdgcn_fence(__ATOMIC_ACQUIRE, "agent");
            asm volatile("s_waitcnt vmcnt(0)" ::: "memory");
        }
    }
    __syncthreads();
}

__device__ __forceinline__ void tr_item(const float* src, int ld_src, const float* gain, bf16* dst, int ld_dst, int k0, int n0s, int n0d, LAS float* scr, int lane) {
#pragma unroll 8
    for (int i = 0; i < 32; ++i) { const int kk = 2 * i + (lane >> 5); float v = src[(size_t)(k0 + kk) * ld_src + n0s + (lane & 31)]; if (gain) v *= gain[k0 + kk]; scr[kk * 33 + (lane & 31)] = v; }
    LDS_WAIT(); asm volatile("" ::: "memory");
    const int c = lane & 7;
#pragma unroll
    for (int j = 0; j < 4; ++j) { const int n = (lane >> 3) + 8 * j; const LAS float* s = scr + (8 * c) * 33 + n;
        u32x4 o; o.x = pk2(s[0 * 33], s[1 * 33]); o.y = pk2(s[2 * 33], s[3 * 33]); o.z = pk2(s[4 * 33], s[5 * 33]); o.w = pk2(s[6 * 33], s[7 * 33]);
        *(u32x4*)(dst + (size_t)(n0d + n) * ld_dst + k0 + 8 * c) = o; }
    LDS_WAIT(); asm volatile("" ::: "memory");
}
__device__ __forceinline__ float row_cvt(const float* xrow, bf16* orow, float* crow, int lane) {
    const f32x4* xr = (const f32x4*)xrow + lane; f32x4 v[4]; float s = 0.f;
#pragma unroll
    for (int j = 0; j < 4; ++j) { v[j] = xr[64 * j]; s += (v[j][0] * v[j][0] + v[j][1] * v[j][1]) + (v[j][2] * v[j][2] + v[j][3] * v[j][3]); }
    u32x2* o8 = (u32x2*)orow + lane;
#pragma unroll
    for (int j = 0; j < 4; ++j) { u32x2 w; w.x = pk2(v[j][0], v[j][1]); w.y = pk2(v[j][2], v[j][3]); o8[64 * j] = w; if (crow) ((f32x4*)crow + lane)[64 * j] = v[j]; }
    return wave_sum(s);
}
__device__ __forceinline__ void phase0(const LP P, LAS unsigned char* lds) {
    const int tid = opaque_tid(), lane = tid & 63, wave = tid >> 6; unsigned char* ws = P.ws();
    LAS float* scr = (LAS float*)(lds + wave * 16384);
    const int gw = blockIdx.x * 8 + wave, NGW = gridDim.x * 8;
    constexpr int PER_L = 1792 + 512 * 5 + 2048 * 2, NW_ITEMS = PER_L * NL, N_CDV = 128 * 128, N_CMV = 128 * 32, N_TR = NW_ITEMS + N_CDV + N_CMV;
    for (int it = gw; it < N_TR; it += NGW) {
        if (it < NW_ITEMS) { const int l = it / PER_L; int r = it % PER_L;
            if (r < 1792) { const int kb = r / 112, nb = r % 112, n0 = nb * 32; tr_item(P.in(I_WIN) + (size_t)l * 1024 * 3592, 3592, P.in(I_LNMIX) + l * 1024, (bf16*)(ws + W_WIN) + (size_t)l * NIN * DM, DM, kb * 64, n0 + (n0 >= 2048 ? 8 : 0), n0, scr, lane); continue; } r -= 1792;
            if (r < 512) { tr_item(P.in(I_WOUT) + (size_t)l * DM * DM, DM, nullptr, (bf16*)(ws + W_WOUT) + (size_t)l * DM * DM, DM, (r >> 5) * 64, (r & 31) * 32, (r & 31) * 32, scr, lane); continue; } r -= 512;
            if (r < 512) { tr_item(P.in(I_WMQ) + (size_t)l * DM * DM, DM, P.in(I_LNMQ) + l * 1024, (bf16*)(ws + W_WQ) + (size_t)l * DM * DM, DM, (r >> 5) * 64, (r & 31) * 32, (r & 31) * 32, scr, lane); continue; } r -= 512;
            if (r < 512) { tr_item(P.in(I_WMK) + (size_t)l * DM * DM, DM, P.in(I_LNMKV) + l * 1024, (bf16*)(ws + W_WKV) + (size_t)l * 2048 * DM, DM, (r >> 5) * 64, (r & 31) * 32, (r & 31) * 32, scr, lane); continue; } r -= 512;
            if (r < 512) { tr_item(P.in(I_WMV) + (size_t)l * DM * DM, DM, P.in(I_LNMKV) + l * 1024, (bf16*)(ws + W_WKV) + (size_t)l * 2048 * DM, DM, (r >> 5) * 64, (r & 31) * 32, 1024 + (r & 31) * 32, scr, lane); continue; } r -= 512;
            if (r < 512) { tr_item(P.in(I_WMO) + (size_t)l * DM * DM, DM, nullptr, (bf16*)(ws + W_WO) + (size_t)l * DM * DM, DM, (r >> 5) * 64, (r & 31) * 32, (r & 31) * 32, scr, lane); continue; } r -= 512;
            if (r < 2048) { tr_item(P.in(I_W1) + (size_t)l * DM * DFF, DFF, P.in(I_LNFFN) + l * 1024, (bf16*)(ws + W_W1) + (size_t)l * DFF * DM, DM, (r >> 7) * 64, (r & 127) * 32, (r & 127) * 32, scr, lane); continue; } r -= 2048;
            tr_item(P.in(I_W2) + (size_t)l * DFF * DM, DM, nullptr, (bf16*)(ws + W_W2) + (size_t)l * DM * DFF, DFF, (r >> 5) * 64, (r & 31) * 32, (r & 31) * 32, scr, lane);
        } else if (it < NW_ITEMS + N_CDV) { const int r = it - NW_ITEMS, lbh = r >> 7, q = r & 127, l = lbh >> 5, b = (lbh >> 2) & 7, h = lbh & 3;
            tr_item(P.in(I_CDV) + ((size_t)(l * 8 + b) * 2048) * 512 + h * 128, 512, nullptr, (bf16*)(ws + W_SVT) + ((size_t)(l * 32 + b * 4 + h) * 128) * 2112, 2112, (q >> 2) * 64, (q & 3) * 32, (q & 3) * 32, scr, lane);
        } else { const int r = it - NW_ITEMS - N_CDV, lbh = r >> 5, q = r & 31, l = lbh >> 5, b = (lbh >> 2) & 7, h = lbh & 3;
            tr_item(P.in(I_CMV) + ((size_t)(l * 8 + b) * 256) * 1024 + h * 256, 1024, nullptr, (bf16*)(ws + W_CMVT) + ((size_t)((l * 8 + b) * 4 + h) * 256) * 256, 256, (q >> 3) * 64, (q & 7) * 32, (q & 7) * 32, scr, lane);
        }
    }
    float* H = P.out() + O_Y; bf16* HB = (bf16*)(ws + W_HB); float* SSQ = (float*)(ws + W_SSQ);
    for (int m = gw; m < TT; m += NGW) { const float* src = m < TP ? P.in(I_XP) + (size_t)m * DM : P.in(I_XS) + (size_t)(m - TP) * DM;
        const float s = row_cvt(src, HB + (size_t)m * DM, nullptr, lane); if (lane < 16) SSQ[(size_t)m * 16 + lane] = lane == 0 ? s : 0.f; }
    for (int m = gw; m < 4096; m += NGW) { const float s = row_cvt(P.in(I_MEM) + (size_t)m * DM, (bf16*)(ws + W_MEMB) + (size_t)m * DM, nullptr, lane); if (lane == 0) ((float*)(ws + W_RINVM))[m] = rsqrtf(s * (1.0f / 1024.0f) + EPS); }
    for (int m = gw; m < NL * 2048; m += NGW) row_cvt(P.in(I_CMK) + (size_t)m * DM, (bf16*)(ws + W_CMK) + (size_t)m * DM, nullptr, lane);
    for (int m = gw; m < NL * 8 * 1024; m += NGW) {
        const int lb = m >> 10, pr = (m & 1023) * 2; row_cvt(P.in(I_CDK) + ((size_t)lb * 2048 + pr) * 512, (bf16*)(ws + W_SK) + ((size_t)lb * 2112 + pr) * 512, nullptr, lane); }
    for (int i = blockIdx.x * 512 + tid; i < NL * 8 * 1024; i += gridDim.x * 512) { const int l = i >> 13, j = (i >> 10) & 7, k = i & 1023;
        ((float*)(ws + W_WAB))[i] = P.in(I_LNMIX)[l * 1024 + k] * P.in(I_WIN)[((size_t)l * 1024 + k) * 3592 + 2048 + j]; }
}

#ifndef G1_UNROLL
#define G1_UNROLL 8
#endif
constexpr int G1_QB = 0, G1_KB = 18432, G1_VBT = 36864, G1_KGT = 57344, G1_AM = 77824, G1_AB16 = 95232, G1_TT = 105472, G1_TB = 115712, G1_RT = 125952, G1_GS = 129024, G1_BT = 129280, G1_GC = 129536;
template <bool SAMPLE>
__device__ __forceinline__ void g1_pass1(const LP P, int l, int h, int cidx, int tok0, bool first, int sb, LAS unsigned char* lds, int lane, int w) {
    unsigned char* ws = P.ws(); const bf16* PROJ = (const bf16*)(ws + W_PROJ); const bf16* HB = (const bf16*)(ws + W_HB); const float* SSQ = (const float*)(ws + W_SSQ);
    LAS float* gs = (LAS float*)(lds + G1_GS); LAS float* bt = (LAS float*)(lds + G1_BT);
    float wa[16], wb[16];
    { const float* pa = (const float*)(ws + W_WAB) + ((size_t)l * 8 + h) * 1024 + 16 * lane; const float* pb = pa + 4 * 1024;
#pragma unroll
      for (int j = 0; j < 4; ++j) { const f32x4 a = *(const f32x4*)(pa + 4 * j), b = *(const f32x4*)(pb + 4 * j);
#pragma unroll
          for (int k = 0; k < 4; ++k) { wa[4 * j + k] = a[k]; wb[4 * j + k] = b[k]; } } }
    float cw[3][4][2];
    { const float* convw = P.in(I_CONVW);
#pragma unroll
    for (int wh = 0; wh < 3; ++wh)
#pragma unroll
        for (int j = 0; j < 4; ++j) { const f32x2v t2 = *(const f32x2v*)(convw + ((size_t)l * 4 + j) * 1536 + wh * 512 + h * 128 + 2 * lane); cw[wh][j][0] = t2[0]; cw[wh][j][1] = t2[1]; } }
    const float na = -__expf(P.in(I_ALOG)[l * 4 + h]), dtb = P.in(I_DTB)[l * 4 + h];
    const float* sgc = SAMPLE ? P.in(I_SGC) : nullptr;
    const float fz = first ? 0.f : 1.f;
#pragma unroll G1_UNROLL
    for (int tt = 0; tt < 8; ++tt) { const int t = 8 * w + tt, tok = tok0 + t;
        float sv[3][2];
#pragma unroll
        for (int wh = 0; wh < 3; ++wh) { float y0 = 0.f, y1 = 0.f;
#pragma unroll
            for (int j = 0; j < 4; ++j) { const int rr = t - 3 + j; float x0, x1;
                if (!SAMPLE) { const int row = (first && rr < 0) ? 0 : rr; const unsigned u = *(const unsigned*)(PROJ + (size_t)wh * TT * 512 + (size_t)(tok0 + row) * 512 + h * 128 + 2 * lane);
                    const float m = rr < 0 ? fz : 1.f; x0 = bf2f(u & 0xffffu) * m; x1 = bf2f(u >> 16) * m; }
                else { if (rr >= 0) { const unsigned u = *(const unsigned*)(PROJ + (size_t)wh * TT * 512 + (size_t)(tok0 + rr) * 512 + h * 128 + 2 * lane); x0 = bf2f(u & 0xffffu); x1 = bf2f(u >> 16); }
                    else { const f32x2v t2 = *(const f32x2v*)(sgc + ((size_t)(l * 8 + sb) * 3 + (3 + rr)) * 1536 + wh * 512 + h * 128 + 2 * lane); x0 = t2[0]; x1 = t2[1]; } }
                y0 += cw[wh][j][0] * x0; y1 += cw[wh][j][1] * x1; }
            sv[wh][0] = y0 / (1.f + __expf(-y0)); sv[wh][1] = y1 / (1.f + __expf(-y1)); }
        const float qs = rsqrtf(wave_sum(sv[0][0] * sv[0][0] + sv[0][1] * sv[0][1]) + EPS) * 0.08838834764831845f;
        const float ks = rsqrtf(wave_sum(sv[1][0] * sv[1][0] + sv[1][1] * sv[1][1]) + EPS);
        *(LAS unsigned*)(lds + G1_QB + t * 288 + lane * 4) = pk2(sv[0][0] * qs, sv[0][1] * qs);
        *(LAS unsigned*)(lds + G1_KB + t * 288 + lane * 4) = pk2(sv[1][0] * ks, sv[1][1] * ks);
        const u32x4 h0 = *(const u32x4*)(HB + (size_t)tok * DM + 16 * lane), h1 = *(const u32x4*)(HB + (size_t)tok * DM + 16 * lane + 8);
        float da = 0.f, db = 0.f;
#pragma unroll
        for (int k = 0; k < 4; ++k) { const float x0 = bf2f(h0[k] & 0xffffu), x1 = bf2f(h0[k] >> 16), x2 = bf2f(h1[k] & 0xffffu), x3 = bf2f(h1[k] >> 16);
            da += x0 * wa[2 * k] + x1 * wa[2 * k + 1] + x2 * wa[8 + 2 * k] + x3 * wa[8 + 2 * k + 1]; db += x0 * wb[2 * k] + x1 * wb[2 * k + 1] + x2 * wb[8 + 2 * k] + x3 * wb[8 + 2 * k + 1]; }
        da = wave_sum(da); db = wave_sum(db);
        const float sq = wave_sum(lane < 16 ? SSQ[(size_t)tok * 16 + lane] : 0.f), rinv = rsqrtf(sq * (1.0f / 1024.0f) + EPS);
        const float xa = da * rinv + dtb, xb = db * rinv;
        const float sp = fmaxf(xa, 0.f) + log1pf(__expf(-fabsf(xa))), gt = na * sp, beta = 1.f / (1.f + __expf(-xb));
        *(LAS bf16*)(lds + G1_VBT + (2 * lane) * 160 + t * 2) = f2bf(beta * sv[2][0]); *(LAS bf16*)(lds + G1_VBT + (2 * lane + 1) * 160 + t * 2) = f2bf(beta * sv[2][1]);
        if (lane == 0) { gs[t] = gt; bt[t] = beta; }
    }
    if (SAMPLE || (cidx & 63) == 63) { float* outp = P.out();
        float* dst = SAMPLE ? outp + O_CS + ((size_t)(l * 8 + sb) * 3) * 1536 : outp + O_CP + ((size_t)(l * 16 + (cidx >> 6)) * 3) * 1536;
        if (w < 3) {
#pragma unroll
            for (int wh = 0; wh < 3; ++wh) { const unsigned u = *(const unsigned*)(PROJ + (size_t)wh * TT * 512 + (size_t)(tok0 + 61 + w) * 512 + h * 128 + 2 * lane);
                f32x2v t2; t2[0] = bf2f(u & 0xffffu); t2[1] = bf2f(u >> 16); *(f32x2v*)(dst + (size_t)w * 1536 + wh * 512 + h * 128 + 2 * lane) = t2; } } }
}

__device__ __forceinline__ void g1_item(const LP P, int l, int item, LAS unsigned char* lds) {
    const int tid = opaque_tid(), lane = tid & 63, w = tid >> 6, r16 = lane & 15, g = lane >> 4; unsigned char* ws = P.ws();
    const int cidx = item >> 2, h = item & 3; const bool prompt = cidx < 1024;
    const int tok0 = prompt ? cidx * 64 : TP + (cidx - 1024) * 64; const bool first = prompt && ((cidx & 63) == 0); const int sb = cidx - 1024;
    const bf16* PROJ = (const bf16*)(ws + W_PROJ); const bf16* HB = (const bf16*)(ws + W_HB); const float* SSQ = (const float*)(ws + W_SSQ);
    LAS float* gs = (LAS float*)(lds + G1_GS); LAS float* bt = (LAS float*)(lds + G1_BT); LAS float* Gc = (LAS float*)(lds + G1_GC);
    LAS float* Am = (LAS float*)(lds + G1_AM);
#ifdef REPEAT_P1
    for (int rp = 0; rp < 2; ++rp) { if (rp) __syncthreads();
#else
    {
#endif
    if (prompt) g1_pass1<false>(P, l, h, cidx, tok0, first, sb, lds, lane, w); else g1_pass1<true>(P, l, h, cidx, tok0, first, sb, lds, lane, w);
    }
    __syncthreads();
    if (w == 0) { float v = gs[lane];
#pragma unroll
        for (int o = 1; o < 64; o <<= 1) { const float n = __shfl_up(v, o); if (lane >= o) v += n; }
        Gc[lane] = v; if (lane == 63) ((float*)(ws + W_GL))[item] = __expf(v); }
    __syncthreads();
    { const int it = w >> 1; bf16* QK = (bf16*)(ws + W_QK) + (size_t)item * 4096;
#pragma unroll
        for (int jj = 0; jj < 2; ++jj) { const int jt = 2 * (w & 1) + jj; f32x4 a1 = {0.f, 0.f, 0.f, 0.f}, a2 = {0.f, 0.f, 0.f, 0.f};
#pragma unroll
            for (int ks = 0; ks < 4; ++ks) { const bf16x8 ki = lfrag(lds + G1_KB, 16 * it + r16, 288, ks * 32 + 8 * g), kj = lfrag(lds + G1_KB, 16 * jt + r16, 288, ks * 32 + 8 * g), qj = lfrag(lds + G1_QB, 16 * jt + r16, 288, ks * 32 + 8 * g);
                a1 = mfma16(ki, kj, a1);
                a2 = mfma16(ki, qj, a2); }
            const int jc = 16 * jt + r16; const float Gj = Gc[jc]; u32x2 o; float v[4];
#pragma unroll
            for (int rg = 0; rg < 4; ++rg) { const int i = 16 * it + 4 * g + rg; const float Gi = Gc[i];
                const float av = (i > jc) ? bt[i] * a1[rg] * __expf(Gi - Gj) : 0.f; Am[i * 68 + jc] = av; *(LAS bf16*)(lds + G1_AB16 + i * 160 + jc * 2) = f2bf(av);
                v[rg] = (jc >= i) ? a2[rg] * __expf(Gj - Gi) : 0.f; }
            o.x = pk2(v[0], v[1]); o.y = pk2(v[2], v[3]); *(u32x2*)(QK + jc * 64 + 16 * it + 4 * g) = o; } }
    __syncthreads();
    if (w == 0) {
        { const u32x4 z4 = {0u, 0u, 0u, 0u};
#pragma unroll
          for (int k = 0; k < 10; ++k) { *(LAS u32x4*)(lds + G1_TB + (k * 64 + lane) * 16) = z4; *(LAS u32x4*)(lds + G1_TT + (k * 64 + lane) * 16) = z4; } }
        LDS_WAIT();
        { const int p = lane >> 4, c = lane & 15; const LAS float* Ab = Am + (16 * p) * 68 + 16 * p; float Tc[16];
#pragma unroll
          for (int i = 0; i < 16; ++i) { float a = (i == c) ? 1.f : 0.f;
#pragma unroll
              for (int j = 0; j < i; ++j) a -= Ab[i * 68 + j] * Tc[j];
              Tc[i] = a; }
#pragma unroll
          for (int i = 0; i < 16; ++i) { const bf16 tb = f2bf(Tc[i]); *(LAS bf16*)(lds + G1_TB + (16 * p + i) * 160 + (16 * p + c) * 2) = tb; *(LAS bf16*)(lds + G1_TT + (16 * p + c) * 160 + (16 * p + i) * 2) = tb; } }
        LDS_WAIT();
        const bf16x8 zf = {0, 0, 0, 0, 0, 0, 0, 0};
#pragma unroll
        for (int p = 1; p < 4; ++p) {
            f32x4 R[3];
#pragma unroll
            for (int nt = 0; nt < p; ++nt) { R[nt] = (f32x4){0.f, 0.f, 0.f, 0.f};
#pragma unroll
                for (int ks = 0; ks < (p + 1) / 2; ++ks) { const bf16x8 af = (ks * 32 + 8 * g < 16 * p) ? lfrag(lds + G1_AB16, 16 * p + r16, 160, ks * 32 + 8 * g) : zf;
                    R[nt] = mfma16(af, lfrag(lds + G1_TT, 16 * nt + r16, 160, ks * 32 + 8 * g), R[nt]); } }
#pragma unroll
            for (int nt = 0; nt < p; ++nt) { u32x2 o; o.x = pk2(-R[nt][0], -R[nt][1]); o.y = pk2(-R[nt][2], -R[nt][3]); *(LAS u32x2*)(lds + G1_RT + (16 * nt + r16) * 48 + 8 * g) = o; }
            LDS_WAIT();
            const bf16x8 tp = (g < 2) ? lfrag(lds + G1_TB, 16 * p + r16, 160, 16 * p + 8 * g) : zf;
#pragma unroll
            for (int nt = 0; nt < p; ++nt) { const bf16x8 rf = (g < 2) ? *(const LAS bf16x8*)(lds + G1_RT + (16 * nt + r16) * 48 + 16 * g) : zf;
                const f32x4 M = mfma16(tp, rf, (f32x4){0.f, 0.f, 0.f, 0.f});
                u32x2 o; o.x = pk2(M[0], M[1]); o.y = pk2(M[2], M[3]); *(LAS u32x2*)(lds + G1_TT + (16 * nt + r16) * 160 + (16 * p + 4 * g) * 2) = o;
#pragma unroll
                for (int rg = 0; rg < 4; ++rg) *(LAS bf16*)(lds + G1_TB + (16 * p + 4 * g + rg) * 160 + (16 * nt + r16) * 2) = f2bf(M[rg]); }
            LDS_WAIT();
        }
    }
    else { bf16* QG = (bf16*)(ws + W_QG) + (size_t)item * 8192; bf16* KDT = (bf16*)(ws + W_KDT) + (size_t)item * 8192; const float Glast = Gc[63];
        for (int idx = tid - 64; idx < 4096; idx += 448) { const int t = idx >> 6, c2 = idx & 63; const unsigned u = *(const LAS unsigned*)(lds + G1_QB + t * 288 + c2 * 4); const float eg = __expf(Gc[t]);
            *(unsigned*)(QG + t * 128 + 2 * c2) = pk2(bf2f(u & 0xffffu) * eg, bf2f(u >> 16) * eg); }
        for (int idx = tid - 64; idx < 8192; idx += 448) { const int c = idx >> 6, t = idx & 63; const float k = bf2f(*(const LAS bf16*)(lds + G1_KB + t * 288 + c * 2)), Gt = Gc[t];
            *(LAS bf16*)(lds + G1_KGT + c * 160 + t * 2) = f2bf(bt[t] * __expf(Gt) * k); KDT[c * 64 + t] = f2bf(k * __expf(Glast - Gt)); } }
    __syncthreads();
    { const int it = w & 3, eh = w >> 2; bf16* UT = (bf16*)(ws + W_UT) + (size_t)item * 8192; bf16* WM = (bf16*)(ws + W_WM) + (size_t)item * 8192;
        bf16x8 tf[2];
#pragma unroll
        for (int ks = 0; ks < 2; ++ks) tf[ks] = lfrag(lds + G1_TB, 16 * it + r16, 160, ks * 32 + 8 * g);
#pragma unroll
        for (int ee = 0; ee < 4; ++ee) { const int et = 4 * eh + ee; f32x4 a1 = {0.f, 0.f, 0.f, 0.f}, a2 = {0.f, 0.f, 0.f, 0.f};
#pragma unroll
            for (int ks = 0; ks < 2; ++ks) { a1 = mfma16(tf[ks], lfrag(lds + G1_VBT, 16 * et + r16, 160, ks * 32 + 8 * g), a1);
                a2 = mfma16(lfrag(lds + G1_KGT, 16 * et + r16, 160, ks * 32 + 8 * g), tf[ks], a2); }
            u32x2 o; o.x = pk2(a1[0], a1[1]); o.y = pk2(a1[2], a1[3]); *(u32x2*)(UT + (16 * et + r16) * 64 + 16 * it + 4 * g) = o;
            o.x = pk2(a2[0], a2[1]); o.y = pk2(a2[2], a2[3]); *(u32x2*)(WM + (16 * it + r16) * 128 + 16 * et + 4 * g) = o; } }
    __syncthreads();
}
#define LDS_BARRIER() asm volatile("s_waitcnt lgkmcnt(0)\n\ts_barrier" ::: "memory")
constexpr int G2_ST0 = 0, G2_ST1 = 36864, G2_VNT = 73728, G2_STAT = 94208;
__device__ __forceinline__ void g2_load_ops(bf16x8 (&o_wf)[4], bf16x8 (&o_qgf)[4], bf16x8 (&o_qkf)[2], bf16x8 (&o_kf)[2], u32x2 (&o_ut)[4], u32x2 (&o_zz)[4], float& o_gl, const bf16* UTb, const bf16* WMb, const bf16* QGb, const bf16* KDTb, const bf16* QKb, const bf16* Z, const float* GL, int item, int tok, int h, int it, int eh, int w, int r16, int g) {
    const bf16* UT = UTb + (size_t)item * 8192; const bf16* WM = WMb + (size_t)item * 8192; const bf16* QG = QGb + (size_t)item * 8192; const bf16* KDT = KDTb + (size_t)item * 8192; const bf16* QK = QKb + (size_t)item * 4096;
#pragma unroll
    for (int ks = 0; ks < 4; ++ks) { o_wf[ks] = gfrag(WM + (16 * it + r16) * 128 + ks * 32 + 8 * g); o_qgf[ks] = gfrag(QG + (16 * it + r16) * 128 + ks * 32 + 8 * g); }
#pragma unroll
    for (int ks = 0; ks < 2; ++ks) { o_qkf[ks] = gfrag(QK + (16 * it + r16) * 64 + ks * 32 + 8 * g); o_kf[ks] = gfrag(KDT + (16 * w + r16) * 64 + ks * 32 + 8 * g); }
#pragma unroll
    for (int ee = 0; ee < 4; ++ee) { const int et = 4 * eh + ee; o_ut[ee] = *(const u32x2*)(UT + (16 * et + r16) * 64 + 16 * it + 4 * g); o_zz[ee] = *(const u32x2*)(Z + (size_t)tok * 512 + h * 128 + 16 * et + 4 * g); }
    (void)o_gl; (void)GL;
}
__device__ __forceinline__ void g2_item(const LP P, int l, int s, LAS unsigned char* lds) {
    const int tid = opaque_tid(), lane = tid & 63, w = tid >> 6, r16 = lane & 15, g = lane >> 4; unsigned char* ws = P.ws();
    const bool prompt = s < 64; const int bh = prompt ? s : s - 64, b = bh >> 2, h = bh & 3;
    const int nch = prompt ? 64 : 1, cidx0 = prompt ? b * 64 : 1024 + b;
    const bf16* UTb = (const bf16*)(ws + W_UT); const bf16* WMb = (const bf16*)(ws + W_WM); const bf16* QGb = (const bf16*)(ws + W_QG); const bf16* KDTb = (const bf16*)(ws + W_KDT);
    const bf16* QKb = (const bf16*)(ws + W_QK); const float* GL = (const float*)(ws + W_GL); const bf16* Z = (const bf16*)(ws + W_PROJ) + (size_t)3 * TT * 512; bf16* MIX = (bf16*)(ws + W_MIX);
    LAS float* stat = (LAS float*)(lds + G2_STAT);
    f32x4 S[8];
    const float* s0 = P.in(I_SG) + ((size_t)(l * 8 + b) * 4 + h) * 16384;
#pragma unroll
    for (int et = 0; et < 8; ++et) {
#pragma unroll
        for (int rg = 0; rg < 4; ++rg) S[et][rg] = prompt ? 0.f : s0[(16 * w + 4 * g + rg) * 128 + 16 * et + r16];
        u32x2 o; o.x = pk2(S[et][0], S[et][1]); o.y = pk2(S[et][2], S[et][3]); *(LAS u32x2*)(lds + G2_ST0 + (16 * et + r16) * 288 + (16 * w + 4 * g) * 2) = o; }
    __syncthreads();
    int cur = G2_ST0, nxt = G2_ST1;
    const int it = w & 3, eh = w >> 2;
    const f32x4 gn0 = *(const f32x4*)(P.in(I_GNORM) + l * 128 + 16 * (4 * eh + 0) + 4 * g), gn1 = *(const f32x4*)(P.in(I_GNORM) + l * 128 + 16 * (4 * eh + 1) + 4 * g),
                gn2 = *(const f32x4*)(P.in(I_GNORM) + l * 128 + 16 * (4 * eh + 2) + 4 * g), gn3 = *(const f32x4*)(P.in(I_GNORM) + l * 128 + 16 * (4 * eh + 3) + 4 * g);
#define G2_LOAD(P_, c_) g2_load_ops(P_##wf, P_##qgf, P_##qkf, P_##kf, P_##ut, P_##zz, P_##gl, UTb, WMb, QGb, KDTb, QKb, Z, GL, (cidx0 + (c_)) * 4 + h, (prompt ? (cidx0 + (c_)) * 64 : TP + b * 64) + 16 * it + r16, h, it, eh, w, r16, g)
    bf16x8 c_wf[4], c_qgf[4], c_qkf[2], c_kf[2], n_wf[4], n_qgf[4], n_qkf[2], n_kf[2]; u32x2 c_ut[4], c_zz[4], n_ut[4], n_zz[4]; float c_gl, n_gl;
    G2_LOAD(c_, 0);
    float glv = (lane < nch) ? GL[(cidx0 + lane) * 4 + h] : 0.f; asm volatile("" : "+v"(glv));
    for (int c = 0; c < nch; ++c) {
        const int tok0 = prompt ? (cidx0 + c) * 64 : TP + b * 64;
        if (c + 1 < nch) G2_LOAD(n_, c + 1);
        {
#pragma unroll
            for (int ee = 0; ee < 4; ++ee) { const int et = 4 * eh + ee; f32x4 a = {0.f, 0.f, 0.f, 0.f};
#pragma unroll
                for (int ks = 0; ks < 4; ++ks) a = mfma16(c_wf[ks], lfrag(lds + cur, 16 * et + r16, 288, ks * 32 + 8 * g), a);
                const u32x2 u = c_ut[ee];
                u32x2 o; o.x = pk2(bf2f(u.x & 0xffffu) - a[0], bf2f(u.x >> 16) - a[1]); o.y = pk2(bf2f(u.y & 0xffffu) - a[2], bf2f(u.y >> 16) - a[3]);
                *(LAS u32x2*)(lds + G2_VNT + (16 * et + r16) * 160 + (16 * it + 4 * g) * 2) = o; } }
        LDS_BARRIER();
        f32x4 o4[4];
        { float ss = 0.f;
#pragma unroll
            for (int ee = 0; ee < 4; ++ee) { const int et = 4 * eh + ee; f32x4 a = {0.f, 0.f, 0.f, 0.f};
#pragma unroll
                for (int ks = 0; ks < 4; ++ks) a = mfma16(lfrag(lds + cur, 16 * et + r16, 288, ks * 32 + 8 * g), c_qgf[ks], a);
#pragma unroll
                for (int ks = 0; ks < 2; ++ks) a = mfma16(lfrag(lds + G2_VNT, 16 * et + r16, 160, ks * 32 + 8 * g), c_qkf[ks], a);
                o4[ee] = a; ss += (a[0] * a[0] + a[1] * a[1]) + (a[2] * a[2] + a[3] * a[3]); }
            ss += __shfl_xor(ss, 16); ss += __shfl_xor(ss, 32);
            if (g == 0) stat[(16 * it + r16) * 2 + eh] = ss; }
        { const float gl = __builtin_bit_cast(float, __builtin_amdgcn_readlane(__builtin_bit_cast(int, glv), c));
#pragma unroll
            for (int et = 0; et < 8; ++et) { f32x4 a = S[et] * gl;
#pragma unroll
                for (int ks = 0; ks < 2; ++ks) a = mfma16(c_kf[ks], lfrag(lds + G2_VNT, 16 * et + r16, 160, ks * 32 + 8 * g), a);
                S[et] = a; u32x2 o; o.x = pk2(a[0], a[1]); o.y = pk2(a[2], a[3]); *(LAS u32x2*)(lds + nxt + (16 * et + r16) * 288 + (16 * w + 4 * g) * 2) = o; } }
        LDS_BARRIER();
        { const int i = 16 * it + r16, tok = tok0 + i; const float rn = rsqrtf((stat[i * 2] + stat[i * 2 + 1]) * (1.0f / 128.0f) + EPS);
#pragma unroll
            for (int ee = 0; ee < 4; ++ee) { const int e = 16 * (4 * eh + ee) + 4 * g; const u32x2 zz = c_zz[ee]; const f32x4 gn = ee == 0 ? gn0 : ee == 1 ? gn1 : ee == 2 ? gn2 : gn3;
                const float z0 = bf2f(zz.x & 0xffffu), z1 = bf2f(zz.x >> 16), z2 = bf2f(zz.y & 0xffffu), z3 = bf2f(zz.y >> 16);
                u32x2 o; o.x = pk2(o4[ee][0] * rn * gn[0] * (z0 / (1.f + __expf(-z0))), o4[ee][1] * rn * gn[1] * (z1 / (1.f + __expf(-z1))));
                o.y = pk2(o4[ee][2] * rn * gn[2] * (z2 / (1.f + __expf(-z2))), o4[ee][3] * rn * gn[3] * (z3 / (1.f + __expf(-z3))));
                *(u32x2*)(MIX + (size_t)tok * DM + h * 128 + e) = o; } }
        if (c + 1 < nch) {
#pragma unroll
            for (int k = 0; k < 4; ++k) { c_wf[k] = n_wf[k]; c_qgf[k] = n_qgf[k]; c_ut[k] = n_ut[k]; c_zz[k] = n_zz[k]; }
#pragma unroll
            for (int k = 0; k < 2; ++k) { c_qkf[k] = n_qkf[k]; c_kf[k] = n_kf[k]; }
            c_gl = n_gl; }
        const int tmp = cur; cur = nxt; nxt = tmp;
    }
    float* so = prompt ? P.out() + O_GP + ((size_t)(l * 16 + b) * 4 + h) * 16384 : P.out() + O_GS + ((size_t)(l * 8 + b) * 4 + h) * 16384;
#pragma unroll
    for (int et = 0; et < 8; ++et)
#pragma unroll
        for (int rg = 0; rg < 4; ++rg) so[(16 * w + 4 * g + rg) * 128 + 16 * et + r16] = S[et][rg];
    __syncthreads();
}

__device__ __forceinline__ int perm32(int rho) { const int n = rho >> 4, i = rho & 15; return 8 * (i >> 2) + 4 * n + (i & 3); }
template <int DQK, int DV, int QT, int KT, bool DIFF>
__device__ __forceinline__ void attn_unit(LAS unsigned char* lds, const bf16* Kg, int ldk, const bf16* VTg, int ldv, const bf16* Qg, int ldq, int ntile_total, int ntile_w, bool active,
                                          float sc, float lam, float oscale, const float* dnorm, bf16* Og, int ldo) {
    constexpr int KW = DIFF ? 2 * DQK : DQK, KSTR = KW * 2 + 32, KBYTES = KT * KSTR, VSTR = KT * 2 + 32, VBYTES = DV * VSTR, STAGE = KBYTES + VBYTES;
    constexpr int PPR = KW / 8, VPR = KT / 8, NET = DV / 16, NKS = DQK / 32, NG = KT / 32;
    static_assert(KT * PPR == 1024 && DV * VPR == 1024 && 2 * STAGE <= 131072, "staging geometry");
    const int tid = opaque_tid(), lane = tid & 63, w = tid >> 6, r16 = lane & 15, g = lane >> 4;
    const int wq = DIFF ? (w & 3) : w, cm = DIFF ? (w >> 2) : 0, qrow0 = wq * QT * 16;
    bf16x8 Qf[QT][NKS];
#pragma unroll
    for (int qt = 0; qt < QT; ++qt)
#pragma unroll
        for (int ks = 0; ks < NKS; ++ks) { if (active) Qf[qt][ks] = gfrag(Qg + (size_t)(qrow0 + qt * 16 + r16) * ldq + cm * DQK + ks * 32 + 8 * g); else Qf[qt][ks] = (bf16x8){0, 0, 0, 0, 0, 0, 0, 0}; }
    f32x4 O[QT][NET]; float mrow[QT], lrow[QT];
#pragma unroll
    for (int qt = 0; qt < QT; ++qt) { mrow[qt] = -INFINITY; lrow[qt] = 0.f;
#pragma unroll
        for (int et = 0; et < NET; ++et) O[qt][et] = (f32x4){0.f, 0.f, 0.f, 0.f}; }
    int ksrc[2], kdst[2], vsrc[2], vdst[2];
#pragma unroll
    for (int i = 0; i < 2; ++i) { const int pp = tid + 512 * i; const int rho = pp / PPR, cp = pp % PPR, key = (rho & ~31) + perm32(rho & 31); ksrc[i] = key * ldk + cp * 8; kdst[i] = rho * KSTR + cp * 16;
        const int e = pp / VPR, vp = pp % VPR; vsrc[i] = e * ldv + vp * 8; vdst[i] = KBYTES + e * VSTR + vp * 16; }
    u32x4 kr[2], vr[2];
#pragma unroll
    for (int i = 0; i < 2; ++i) { kr[i] = *(const u32x4*)(Kg + ksrc[i]); vr[i] = *(const u32x4*)(VTg + vsrc[i]); }
#pragma unroll
    for (int i = 0; i < 2; ++i) { *(LAS u32x4*)(lds + kdst[i]) = kr[i]; *(LAS u32x4*)(lds + vdst[i]) = vr[i]; }
    __syncthreads();
    for (int j = 0; j < ntile_total; ++j) {
        const LAS unsigned char* Kb = lds + (j & 1) * STAGE; const LAS unsigned char* Vb = Kb + KBYTES;
        if (j + 1 < ntile_total) {
#pragma unroll
            for (int i = 0; i < 2; ++i) { kr[i] = *(const u32x4*)(Kg + (size_t)(j + 1) * KT * ldk + ksrc[i]); vr[i] = *(const u32x4*)(VTg + (size_t)(j + 1) * KT + vsrc[i]); } }
        if (active && j < ntile_w) {
            f32x4 Sx[QT][NG][2];
#pragma unroll
            for (int G = 0; G < NG; ++G)
#pragma unroll
                for (int t = 0; t < 2; ++t) {
#pragma unroll
                    for (int qt = 0; qt < QT; ++qt) Sx[qt][G][t] = (f32x4){0.f, 0.f, 0.f, 0.f};
#pragma unroll
                    for (int ks = 0; ks < NKS; ++ks) { const bf16x8 a = lfrag(Kb, 32 * G + 16 * t + r16, KSTR, cm * DQK + ks * 32 + 8 * g);
#pragma unroll
                        for (int qt = 0; qt < QT; ++qt) Sx[qt][G][t] = mfma16(a, Qf[qt][ks], Sx[qt][G][t]); } }
            bf16x8 pb[QT][NG];
#pragma unroll
            for (int qt = 0; qt < QT; ++qt) { float mx = -INFINITY;
#pragma unroll
                for (int G = 0; G < NG; ++G)
#pragma unroll
                    for (int t = 0; t < 2; ++t)
#pragma unroll
                        for (int rg = 0; rg < 4; ++rg) mx = fmaxf(mx, Sx[qt][G][t][rg]);
                mx = fmaxf(mx, __shfl_xor(mx, 16)); mx = fmaxf(mx, __shfl_xor(mx, 32)); mx *= sc;
                const float mnew = fmaxf(mrow[qt], mx), alpha = __builtin_amdgcn_exp2f(mrow[qt] - mnew), nm = -mnew; mrow[qt] = mnew; float ps = 0.f;
#pragma unroll
                for (int G = 0; G < NG; ++G) { float pv[8];
#pragma unroll
                    for (int t = 0; t < 2; ++t)
#pragma unroll
                        for (int rg = 0; rg < 4; ++rg) { const float e = __builtin_amdgcn_exp2f(fmaf(Sx[qt][G][t][rg], sc, nm)); pv[4 * t + rg] = e; ps += e; }
                    u32x4 pk; pk.x = pk2(pv[0], pv[1]); pk.y = pk2(pv[2], pv[3]); pk.z = pk2(pv[4], pv[5]); pk.w = pk2(pv[6], pv[7]); pb[qt][G] = __builtin_bit_cast(bf16x8, pk); }
                lrow[qt] = lrow[qt] * alpha + ps;
                if (__builtin_amdgcn_ballot_w64(alpha != 1.0f) != 0ull) {
#pragma unroll
                    for (int et = 0; et < NET; ++et) O[qt][et] *= alpha; } }
#pragma unroll
            for (int et = 0; et < NET; ++et)
#pragma unroll
                for (int G = 0; G < NG; ++G) { const bf16x8 a = lfrag(Vb, 16 * et + r16, VSTR, 32 * G + 8 * g);
#pragma unroll
                    for (int qt = 0; qt < QT; ++qt) O[qt][et] = mfma16(a, pb[qt][G], O[qt][et]); }
        }
        if (j + 1 < ntile_total) { LAS unsigned char* nb = lds + ((j + 1) & 1) * STAGE;
#pragma unroll
            for (int i = 0; i < 2; ++i) { *(LAS u32x4*)(nb + kdst[i]) = kr[i]; *(LAS u32x4*)(nb + vdst[i]) = vr[i]; } }
        __syncthreads();
    }
    if (active) {
#pragma unroll
        for (int qt = 0; qt < QT; ++qt) { float lt = lrow[qt]; lt += __shfl_xor(lt, 16); lt += __shfl_xor(lt, 32); const float inv = 1.f / lt;
#pragma unroll
            for (int et = 0; et < NET; ++et) O[qt][et] *= inv; } }
    if constexpr (DIFF) {
        LAS f32x4* ex = (LAS f32x4*)lds;
        if (active && cm == 1) {
#pragma unroll
            for (int qt = 0; qt < QT; ++qt)
#pragma unroll
                for (int et = 0; et < NET; ++et) ex[((wq * QT + qt) * NET + et) * 64 + lane] = O[qt][et]; }
        __syncthreads();
        if (active && cm == 0) {
#pragma unroll
            for (int qt = 0; qt < QT; ++qt) { float ss = 0.f;
#pragma unroll
                for (int et = 0; et < NET; ++et) { const f32x4 o2 = ex[((wq * QT + qt) * NET + et) * 64 + lane]; const f32x4 o = O[qt][et] - o2 * lam; O[qt][et] = o; ss += (o[0] * o[0] + o[1] * o[1]) + (o[2] * o[2] + o[3] * o[3]); }
                ss += __shfl_xor(ss, 16); ss += __shfl_xor(ss, 32); const float rn = rsqrtf(ss * (1.0f / DV) + EPS) * oscale;
                bf16* orow = Og + (size_t)(qrow0 + qt * 16 + r16) * ldo;
#pragma unroll
                for (int et = 0; et < NET; ++et) { const f32x4 gn = *(const f32x4*)(dnorm + 16 * et + 4 * g); const f32x4 o = O[qt][et]; u32x2 pk; pk.x = pk2(o[0] * rn * gn[0], o[1] * rn * gn[1]); pk.y = pk2(o[2] * rn * gn[2], o[3] * rn * gn[3]);
                    *(u32x2*)(orow + 16 * et + 4 * g) = pk; } } }
        __syncthreads();
    } else {
        if (active) {
#pragma unroll
            for (int qt = 0; qt < QT; ++qt) { bf16* orow = Og + (size_t)(qrow0 + qt * 16 + r16) * ldo;
#pragma unroll
                for (int et = 0; et < NET; ++et) { const f32x4 o = O[qt][et]; u32x2 pk; pk.x = pk2(o[0], o[1]); pk.y = pk2(o[2], o[3]); *(u32x2*)(orow + 16 * et + 4 * g) = pk; } } }
    }
}
__device__ __forceinline__ float lam_full(const LP P, int l, int lane, float lam_init) {
    const float a = wave_sum(P.in(I_LQ1)[l * 64 + lane] * P.in(I_LK1)[l * 64 + lane]), b = wave_sum(P.in(I_LQ2)[l * 64 + lane] * P.in(I_LK2)[l * 64 + lane]);
    return __expf(a) - __expf(b) + lam_init;
}
enum { M_IN = 0, M_RES = 1, M_ROW = 2, M_ROWSQ = 3, M_MEMKV = 4 };
struct EpiU {
    static constexpr bool PERM = true, AFTER_DRAIN = false;
    int mode, l; LP P;
    __device__ __forceinline__ void operator()(const f32x4 (&acc)[2][2][4][2], const pg8::Unit& u, int wr, int wc, int fr, int fq) const {
        unsigned char* ws = P.ws(); float* outp = P.out(); float* SSQ = (float*)(ws + W_SSQ);
        if (mode == M_IN) { EpiIn e{SSQ, (bf16*)(ws + W_PROJ), (bf16*)(ws + W_PVT), (bf16*)(ws + W_SVT) + (size_t)l * 32 * 128 * 2112, (bf16*)(ws + W_SK) + (size_t)l * 8 * 2112 * 512,
                                    outp + O_KP + (size_t)l * TP * 512, outp + O_VP + (size_t)l * TP * 512, outp + O_KS + (size_t)l * TS * 512, outp + O_VS + (size_t)l * TS * 512}; e(acc, u, wr, wc, fr, fq); }
        else if (mode == M_RES) { EpiRes e{outp + O_Y, (bf16*)(ws + W_HB), SSQ}; e(acc, u, wr, wc, fr, fq); }
        else if (mode == M_ROW) { EpiRow<0> e{SSQ, (bf16*)(ws + W_QM), DM}; e(acc, u, wr, wc, fr, fq); }
        else if (mode == M_ROWSQ) { EpiRow<1> e{SSQ, (bf16*)(ws + W_FH), DFF}; e(acc, u, wr, wc, fr, fq); }
        else { EpiMemKV e{(const float*)(ws + W_RINVM), outp + O_MKP, outp + O_MVP, (bf16*)(ws + W_MKB), (bf16*)(ws + W_MVT)}; e(acc, u, wr, wc, fr, fq); }
    }
};

__global__ void __launch_bounds__(512) mega_fwd(Params p) {
    extern __shared__ __attribute__((aligned(16))) unsigned char lds_raw[];
    LAS unsigned char* lds = (LAS unsigned char*)lds_raw;
    cg::grid_group grid = cg::this_grid();
    const int G = gridDim.x, bx = blockIdx.x;
    { const int tid = threadIdx.x;
    if (tid == 0) { LAS unsigned long long* q = (LAS unsigned long long*)(lds + LDS_PARAMS);
#pragma unroll
        for (int i = 0; i < 31; ++i) q[i] = (unsigned long long)p.in[i];
        q[31] = (unsigned long long)p.out; q[32] = (unsigned long long)p.ws; }
    if (tid < 2) ((volatile LAS unsigned*)(lds + LDS_PARAMS + 384))[tid] = 0u;
    }
    __syncthreads();
    const LP P{(volatile LAS const unsigned*)(lds + LDS_PARAMS)};
    grid.sync();
    (void)xcd_barrier_post((unsigned*)(P.ws() + W_CTL), (volatile LAS unsigned*)(lds + LDS_PARAMS + 384));
#define GRID_BAR() do { XcdBarrier bar_; bar_.bar = (unsigned*)(P.ws() + W_CTL); bar_.x = xb_xcc_id(); bar_.st = (volatile LAS unsigned*)(lds + LDS_PARAMS + 384); xcd_barrier(bar_); } while (0)
    #ifndef MAXPH
#define MAXPH (NL * 9)
#endif
    for (int ph = -2; ph < MAXPH; ++ph) {
        const int l = ph < 0 ? 0 : ph / 9, st = ph < 0 ? ph : ph % 9;
        unsigned char* ws = P.ws(); float* const outp = P.out();
        float* H = outp + O_Y; bf16* HB = (bf16*)(ws + W_HB); float* SSQ = (float*)(ws + W_SSQ); bf16* PROJ = (bf16*)(ws + W_PROJ); bf16* MIX = (bf16*)(ws + W_MIX);
        bf16* QM = (bf16*)(ws + W_QM); bf16* MA = (bf16*)(ws + W_MA); bf16* FH = (bf16*)(ws + W_FH);
        bf16* SVT_l = (bf16*)(ws + W_SVT) + (size_t)l * 32 * 128 * 2112; bf16* SK_l = (bf16*)(ws + W_SK) + (size_t)l * 8 * 2112 * 512;
        const float lam_init = 0.8f - 0.6f * __expf(-0.3f * (float)l);
#ifdef REPEAT_ST
        for (int rep = 0; rep < ((st == REPEAT_ST) ? 2 : 1); ++rep) {
#else
        {
#endif
        if (st == -2) phase0(P, lds);
        else if (st == 1 || st == 2) {
            const int tid = opaque_tid(), lane = tid & 63, w = tid >> 6;
            const float lam = lam_full(P, l, lane, lam_init); const float scd = 0.125f * 1.4426950408889634f; const float* dn = P.in(I_DNORM) + l * 128;
            const bf16* QD = PROJ + (size_t)4 * TT * 512; const bf16* KD = PROJ + (size_t)5 * TT * 512; const bf16* PVT = (const bf16*)(ws + W_PVT);
            unsigned* qctr = (unsigned*)(ws + W_CTL) + 3584 + 64 * (l * 8 + (bx & 7));
            volatile LAS int* slot = (volatile LAS int*)(lds + LDS_PARAMS + 400);
            int k = 0, pend = -1;
            for (;;) {
                int type, arg;
                if (pend >= 0) { type = 1; arg = 64 + pend; pend = -1; }
                else if (st == 1) { int it = bx + k * G; if (it >= 4096) break;
                    if (G == 256) it = ((k * 64 + (bx & 7) * 8 + (bx >> 5)) << 2) + ((bx >> 3) & 3);
                    ++k; type = 0; arg = it; }
                else if (bx + k * G < 64) { type = 1; arg = bx + k * G; ++k; }
                else {
                    if (tid == 0) *slot = (int)__hip_atomic_fetch_add(qctr, 1u, __ATOMIC_RELAXED, __HIP_MEMORY_SCOPE_AGENT);
                    __syncthreads();
                    const int u = *slot;
                    __syncthreads();
                    if (u >= 4 + 256 + 4) break;
                    const int xq = bx & 7;
                    if (u < 4) { const int su = xq * 4 + u; type = 0; arg = 4096 + su; pend = su; }
                    else { const int v = u - 4; type = 2;
                        if (v < 128) arg = (v >> 3) * 64 + xq * 8 + (v & 7);
                        else if (v < 132) arg = 1024 + xq * 4 + (v - 128);
                        else { const int v2 = v - 4; arg = (v2 >> 3) * 64 + xq * 8 + (v2 & 7) + 32; } }
                }
                if (type == 0) g1_item(P, l, arg, lds);
                else if (type == 1) g2_item(P, l, arg, lds);
                else { const int u = arg; const bool isP = !(u >= 1024 && u < 1056);
                    const bf16 *Kg, *VTg, *Qg; bf16* Og; int ldv, ntt, ntw; bool act;
                    if (isP) { const int up = u < 1024 ? u : u - 32, qb = 31 - (up >> 6), bh = up & 63, b = bh >> 2, h = bh & 3;
                        Kg = KD + (size_t)b * 4096 * 512 + h * 128; VTg = PVT + (size_t)bh * 128 * 4096; ldv = 4096; Qg = QD + ((size_t)b * 4096 + 128 * qb) * 512 + h * 128;
                        ntt = 2 * qb + 2; ntw = 2 * qb + 1 + ((w & 3) >> 1); act = true; Og = MIX + ((size_t)b * 4096 + 128 * qb) * DM + 512 + h * 128; }
                    else { const int su = u - 1024, b = su >> 2, h = su & 3; Kg = SK_l + (size_t)b * 2112 * 512 + h * 128; VTg = SVT_l + (size_t)su * 128 * 2112; ldv = 2112; Qg = QD + ((size_t)TP + 64 * b) * 512 + h * 128;
                        ntt = 33; ntw = 33; act = (w & 3) < 2; Og = MIX + ((size_t)TP + 64 * b) * DM + 512 + h * 128; }
                    attn_unit<64, 128, 2, 64, true>(lds, Kg, 512, VTg, ldv, Qg, 512, ntt, ntw, act, scd, lam, 1.f - lam_init, dn, Og, DM); }
            }
        }
        else if (st == 5) {
            const int w = opaque_tid() >> 6;
            const float scm = 0.0625f * 1.4426950408889634f;
            for (int u = bx; u < 2048 + 32; u += G) { const bf16 *Kg, *VTg, *Qg; bf16* Og; bool act;
                if (u < 2048) { const int tb = u >> 2, h = u & 3, b = tb >> 5; Kg = (const bf16*)(ws + W_MKB) + ((size_t)l * 4096 + b * 256) * DM + h * 256; VTg = (const bf16*)(ws + W_MVT) + ((size_t)(l * 16 + b) * 4 + h) * 65536;
                    Qg = QM + (size_t)tb * 128 * DM + h * 256; Og = MA + (size_t)tb * 128 * DM + h * 256; act = true; }
                else { const int v = u - 2048, b = v >> 2, h = v & 3; Kg = (const bf16*)(ws + W_CMK) + ((size_t)(l * 8 + b) * 256) * DM + h * 256; VTg = (const bf16*)(ws + W_CMVT) + ((size_t)(l * 8 + b) * 4 + h) * 65536;
                    Qg = QM + ((size_t)TP + 64 * b) * DM + h * 256; Og = MA + ((size_t)TP + 64 * b) * DM + h * 256; act = w < 4; }
                attn_unit<256, 256, 1, 32, false>(lds, Kg, DM, VTg, 256, Qg, DM, 8, 8, act, scm, 0.f, 0.f, nullptr, Og, DM); }
        }
        else {
            EpiU E{0, l, P}; const bf16* A; const bf16* Bt; int M = TT, N = DM, K = DM;
            if (st == -1) { E.mode = M_MEMKV; A = (const bf16*)(ws + W_MEMB); Bt = (const bf16*)(ws + W_WKV); M = 4096; N = NL * 2048; }
            else if (st == 0) { E.mode = M_IN; A = HB; Bt = (const bf16*)(ws + W_WIN) + (size_t)l * NIN * DM; N = NIN; }
            else if (st == 3) { E.mode = M_RES; A = MIX; Bt = (const bf16*)(ws + W_WOUT) + (size_t)l * DM * DM; }
            else if (st == 4) { E.mode = M_ROW; A = HB; Bt = (const bf16*)(ws + W_WQ) + (size_t)l * DM * DM; }
            else if (st == 6) { E.mode = M_RES; A = MA; Bt = (const bf16*)(ws + W_WO) + (size_t)l * DM * DM; }
            else if (st == 7) { E.mode = M_ROWSQ; A = HB; Bt = (const bf16*)(ws + W_W1) + (size_t)l * DFF * DM; N = DFF; }
            else { E.mode = M_RES; A = FH; Bt = (const bf16*)(ws + W_W2) + (size_t)l * DM * DFF; K = DFF; }
            pg8::Gemm g{A, Bt, M, N, K}; pg8::StaticOrder S; S.init(M, N, G, bx);
            pg8::gemm_phase<EpiU, pg8::StaticOrder, true, true>(lds, g, S, E);
        }
        if (st != -1) GRID_BAR();
#ifdef DOUBLE_BAR
        GRID_BAR();
#endif
        }
    }
#ifdef DIAG_DUMP_G1
    {
        const int tid = opaque_tid(); unsigned char* ws = P.ws(); float* o = P.out(); const size_t SL = (size_t)TP * 512;
        const bf16* srcs[5] = {(const bf16*)(ws + W_UT), (const bf16*)(ws + W_WM), (const bf16*)(ws + W_QG), (const bf16*)(ws + W_KDT), (const bf16*)(ws + W_QK)};
        float* dsts[5] = {o + O_KP + SL, o + O_KP + 2 * SL, o + O_KP + 3 * SL, o + O_VP + SL, o + O_VP + 2 * SL};
#pragma unroll
        for (int k = 0; k < 5; ++k) { if (!((DIAG_DUMP_G1 >> k) & 1)) continue; const size_t n = k < 4 ? SL : (size_t)NITEM * 4096; for (size_t i = (size_t)bx * 512 + tid; i < n; i += (size_t)G * 512) dsts[k][i] = bf2f(srcs[k][i]); }
        if (DIAG_DUMP_G1 & 32) for (size_t i = (size_t)bx * 512 + tid; i < NITEM; i += (size_t)G * 512) (o + O_VP + 3 * SL)[i] = ((const float*)(ws + W_GL))[i];
    }
#endif
    { const int tid = opaque_tid(), lane = tid & 63, w = tid >> 6; float* Y = P.out() + O_Y; const bf16* HBf = (const bf16*)(P.ws() + W_HB); const int gw = bx * 8 + w, NGW = G * 8; const f32x4* gf = (const f32x4*)P.in(I_LNF);
        for (int m = gw; m < TT; m += NGW) { const u32x4* hr = (const u32x4*)(HBf + (size_t)m * DM) + lane; f32x4 v[4]; float s = 0.f;
#pragma unroll
            for (int j = 0; j < 2; ++j) { const u32x4 hv = hr[64 * j]; v[2 * j][0] = bf2f(hv.x & 0xffffu); v[2 * j][1] = bf2f(hv.x >> 16); v[2 * j][2] = bf2f(hv.y & 0xffffu); v[2 * j][3] = bf2f(hv.y >> 16);
                v[2 * j + 1][0] = bf2f(hv.z & 0xffffu); v[2 * j + 1][1] = bf2f(hv.z >> 16); v[2 * j + 1][2] = bf2f(hv.w & 0xffffu); v[2 * j + 1][3] = bf2f(hv.w >> 16); }
#pragma unroll
            for (int j = 0; j < 4; ++j) s += (v[j][0] * v[j][0] + v[j][1] * v[j][1]) + (v[j][2] * v[j][2] + v[j][3] * v[j][3]);
            const float rn = rsqrtf(wave_sum(s) * (1.0f / 1024.0f) + EPS);
            f32x4* yr = (f32x4*)(Y + (size_t)m * DM);
#pragma unroll
            for (int j = 0; j < 2; ++j) { const int c4 = 2 * lane + 128 * j; yr[c4] = v[2 * j] * rn * gf[c4]; yr[c4 + 1] = v[2 * j + 1] * rn * gf[c4 + 1]; } } }
}

extern "C" void kernel_launch(void* const* d_in, const int* in_sizes, int n_in, void* d_out, int out_size, void* d_ws, size_t ws_size, hipStream_t stream) {
    static int grid = 0;
    if (grid == 0) {
        if (n_in != 31 || (size_t)out_size != O_END || ws_size < W_END) { fprintf(stderr, "kernel_launch: unexpected shapes (n_in %d out %d ws %zu need %zu)\n", n_in, out_size, ws_size, (size_t)W_END); grid = -1; return; }
        int dev = 0, cus = 0, per_cu = 0;
        (void)hipGetDevice(&dev); (void)hipDeviceGetAttribute(&cus, hipDeviceAttributeMultiprocessorCount, dev);
        if (hipFuncSetAttribute((const void*)mega_fwd, hipFuncAttributeMaxDynamicSharedMemorySize, LDS_BYTES) != hipSuccess) { fprintf(stderr, "kernel_launch: hipFuncSetAttribute failed\n"); }
        if (hipOccupancyMaxActiveBlocksPerMultiprocessor(&per_cu, (const void*)mega_fwd, 512, LDS_BYTES) != hipSuccess || per_cu < 1) { fprintf(stderr, "kernel_launch: occupancy query says %d\n", per_cu); per_cu = 1; }
        (void)hipGetLastError();
        grid = cus * 1;
    }
    if (grid < 0) return;
    (void)hipMemsetAsync((unsigned char*)d_ws + W_CTL, 0, CTL_BYTES, stream);
    Params p{};
    for (int i = 0; i < 31; ++i) p.in[i] = (const float*)d_in[i];
    p.out = (float*)d_out; p.ws = (unsigned char*)d_ws;
    void* args[] = {&p};
    hipError_t e = hipLaunchCooperativeKernel((const void*)mega_fwd, dim3(grid), dim3(512), args, LDS_BYTES, stream);
    if (e != hipSuccess) fprintf(stderr, "kernel_launch: cooperative launch failed: %s (grid %d)\n", hipGetErrorString(e), grid);
}
```

```cpp
#include <hip/hip_runtime.h>
#include <hip/hip_cooperative_groups.h>
#include <cstdio>
namespace cg = cooperative_groups;
__device__ __forceinline__ int opaque_tid() { int t = threadIdx.x; asm volatile("" : "+v"(t)); return t; }
namespace pg8 {
#define PG8_LAS __attribute__((address_space(3)))
typedef unsigned short bf16_t;
typedef short bf16x8 __attribute__((ext_vector_type(8)));
typedef float f32x4 __attribute__((ext_vector_type(4)));
typedef unsigned u32x4 __attribute__((ext_vector_type(4)));
constexpr int BM = 256, BK = 64, HALF = 128, HTB = HALF * BK * 2  , STAGE_BYTES = 8 * HTB, NXCD = 8, WGM = 8;

__host__ __device__ __forceinline__ int lds_byte(int r, int c) { const int st = (r >> 4) * 2 + (c >> 5), rr = r & 15, cc = c & 31, ob = rr * 64 + cc * 2; return st * 1024 + (ob ^ (((ob >> 9) & 1) << 5)); }
__host__ __device__ __forceinline__ void stage_rc(int b, int& R, int& C) { const int st = b / 1024, sb = b % 1024, swz = sb ^ (((sb >> 9) & 1) << 5); R = (st >> 1) * 16 + swz / 64; C = (st & 1) * 32 + (swz % 64) / 2; }
__host__ __device__ __forceinline__ int perm32(int rho) { const int n = rho >> 4, i = rho & 15; return 8 * (i >> 2) + 4 * n + (i & 3); }

struct Unit { int pm, pn; };
struct Gemm { const bf16_t* A; const bf16_t* Bt; int M, N, K; };

struct StaticOrder {
    int nM, nN, nwg, G, c;
    __host__ __device__ void init(int M, int N, int G_, int c_) { nM = M / BM; nN = N / BM; nwg = nM * nN; G = G_; c = c_; }
    __host__ __device__ bool next(int i, Unit& u) const {
        const long L = (long)i * G + c; if (L >= nwg) return false;
        int wgid = (int)L; { const int q = nwg / NXCD, r = nwg % NXCD, xcd = wgid % NXCD, off = wgid / NXCD; wgid = (xcd < r ? xcd * (q + 1) : r * (q + 1) + (xcd - r) * q) + off; }
        const int nig = WGM * nN, gid = wgid / nig, fm = gid * WGM, gsz = (nM - fm) < WGM ? (nM - fm) : WGM;
        u.pm = fm + ((wgid % nig) % gsz); u.pn = (wgid % nig) / gsz; return true;
    }
    __device__ __forceinline__ void a_ready(const Unit&) const {}
    __device__ __forceinline__ void done(const Unit&) const {}
};

__device__ __forceinline__ unsigned cvt_pk_bf16(float lo, float hi) { unsigned r; asm volatile("v_cvt_pk_bf16_f32 %0, %1, %2" : "=v"(r) : "v"(lo), "v"(hi)); return r; }
typedef float f32x2 __attribute__((ext_vector_type(2)));
template <class Epi, class Sched, bool ALIGN_EPI = false, bool SP2 = false>
__device__ __forceinline__ void gemm_phase(PG8_LAS unsigned char* lds, const Gemm g, const Sched& S, const Epi& E) {
    const int tid = opaque_tid(), wid = __builtin_amdgcn_readfirstlane(tid >> 6), lane = tid & 63, wr = wid >> 2, wc = wid & 3, fr = lane & 15, fq = lane >> 4;
    const int K = g.K, nt = K / BK;
    unsigned voffA[2], voffB[2];
#pragma unroll
    for (int i = 0; i < 2; ++i) { int R, C; stage_rc(tid * 16 + i * 8192, R, C); const int Rb = Epi::PERM ? ((R & ~31) + perm32(R & 31)) : R;
        voffA[i] = (unsigned)(R * K + C) * 2u; voffB[i] = (unsigned)(Rb * K + C) * 2u; }
    const size_t kstep = (size_t)(BK * 2);
    const size_t hstep = (size_t)HALF * K * 2;
    const size_t tstep = 2 * hstep;
    const unsigned ldsw = (unsigned)wid * 1024u;
    const int aoff = lds_byte(wr * 64 + fr, fq * 8), boff = lds_byte(wc * 32 + fr, fq * 8);
#define PG8_SA(b, h) (((b) * 2 + (h)) * HTB)
#define PG8_SB(b, h) ((4 + (b) * 2 + (h)) * HTB)
#define PG8_STAGE(bufoff, gbase, voff) do { _Pragma("unroll") for (int _i = 0; _i < 2; ++_i) \
        __builtin_amdgcn_global_load_lds((const unsigned*)((const char*)(gbase) + (voff)[_i]), (PG8_LAS unsigned*)(lds + (bufoff) + ldsw + _i * 8192), 16, 0, 0); } while (0)
#define PG8_LDA(dst, b, h) do { _Pragma("unroll") for (int m = 0; m < 4; ++m) _Pragma("unroll") for (int k = 0; k < 2; ++k) dst[m][k] = *(const PG8_LAS bf16x8*)(lds + PG8_SA(b, h) + aoff + m * 2048 + k * 1024); } while (0)
#define PG8_LDB(dst, b, h) do { _Pragma("unroll") for (int n = 0; n < 2; ++n) _Pragma("unroll") for (int k = 0; k < 2; ++k) dst[n][k] = *(const PG8_LAS bf16x8*)(lds + PG8_SB(b, h) + boff + n * 2048 + k * 1024); } while (0)
#define PG8_MMA(ai, bj, At, Bt) do { __builtin_amdgcn_s_setprio(1); _Pragma("unroll") for (int m = 0; m < 4; ++m) _Pragma("unroll") for (int n = 0; n < 2; ++n) _Pragma("unroll") for (int k = 0; k < 2; ++k) \
        acc[ai][bj][m][n] = __builtin_amdgcn_mfma_f32_16x16x32_bf16(Bt[n][k], At[m][k], acc[ai][bj][m][n], 0, 0, 0); __builtin_amdgcn_s_setprio(0); } while (0)
#define PG8_WAIT_V(n) asm volatile("s_waitcnt vmcnt(" #n ")" ::: "memory")
#define PG8_WAIT_L(n) asm volatile("s_waitcnt lgkmcnt(" #n ")" ::: "memory")
#define PG8_BAR __builtin_amdgcn_s_barrier()
#define PG8_SCHED __builtin_amdgcn_sched_barrier(0)
    Unit cur, nxt; int ui = 0;
    if (!S.next(0, cur)) return;
    f32x4 acc[2][2][4][2];
#pragma unroll
    for (int a = 0; a < 2; ++a)
#pragma unroll
        for (int b = 0; b < 2; ++b)
#pragma unroll
            for (int m = 0; m < 4; ++m)
#pragma unroll
                for (int n = 0; n < 2; ++n) acc[a][b][m][n] = (f32x4){0.f, 0.f, 0.f, 0.f};
    bf16x8 At[4][2], B0[2][2], B1[2][2];
    const char* cA = (const char*)g.A + (size_t)cur.pm * tstep; const char* cB = (const char*)g.Bt + (size_t)cur.pn * tstep;
    S.a_ready(cur);
    if constexpr (SP2) {
        PG8_STAGE(PG8_SB(0, 0), cB, voffB); PG8_STAGE(PG8_SB(0, 1), cB + hstep, voffB); PG8_STAGE(PG8_SA(0, 0), cA, voffA); PG8_STAGE(PG8_SA(0, 1), cA + hstep, voffA);
        if (wr == 1) PG8_BAR;
        PG8_WAIT_V(2); PG8_BAR;
        PG8_STAGE(PG8_SB(1, 0), cB + kstep, voffB); PG8_STAGE(PG8_SA(1, 0), cA + kstep, voffA); PG8_STAGE(PG8_SB(1, 1), cB + hstep + kstep, voffB);
        PG8_WAIT_V(6); PG8_BAR;
    } else {
        PG8_STAGE(PG8_SB(0, 0), cB, voffB); PG8_STAGE(PG8_SA(0, 0), cA, voffA); PG8_STAGE(PG8_SB(0, 1), cB + hstep, voffB); PG8_STAGE(PG8_SA(0, 1), cA + hstep, voffA);
        if (wr == 1) PG8_BAR;
        PG8_WAIT_V(4); PG8_BAR;
        PG8_STAGE(PG8_SB(1, 0), cB + kstep, voffB); PG8_STAGE(PG8_SA(1, 0), cA + kstep, voffA); PG8_STAGE(PG8_SB(1, 1), cB + hstep + kstep, voffB);
        PG8_WAIT_V(6); PG8_BAR;
    }
    for (;;) {
        const bool has_next = S.next(ui + 1, nxt);
        const char* nA = has_next ? (const char*)g.A + (size_t)nxt.pm * tstep : cA; const char* nB = has_next ? (const char*)g.Bt + (size_t)nxt.pn * tstep : cB;
        for (int t = 0; t < nt; t += 2) {
            const bool last = (t == nt - 2);
            const char* a1 = cA + (size_t)(t + 1) * kstep;
            const char* a2 = last ? nA : cA + (size_t)(t + 2) * kstep; const char* b2 = last ? nB : cB + (size_t)(t + 2) * kstep;
            const char* a3 = a2 + kstep; const char* b3 = b2 + kstep;
            if (last && has_next) S.a_ready(nxt);
            if constexpr (SP2) {
            PG8_LDB(B0, 0, 0); PG8_LDB(B1, 0, 1); PG8_SCHED; PG8_LDA(At, 0, 0); PG8_STAGE(PG8_SA(1, 1), a1 + hstep, voffA);
            PG8_WAIT_V(8); PG8_WAIT_L(0); PG8_BAR; PG8_MMA(0, 0, At, B0); PG8_MMA(0, 1, At, B1); PG8_BAR; PG8_SCHED;
            PG8_LDA(At, 0, 1); PG8_STAGE(PG8_SB(0, 0), b2, voffB); PG8_STAGE(PG8_SB(0, 1), b2 + hstep, voffB); PG8_STAGE(PG8_SA(0, 0), a2, voffA);
            PG8_WAIT_V(8); PG8_WAIT_L(0); PG8_BAR; PG8_MMA(1, 0, At, B0); PG8_MMA(1, 1, At, B1); PG8_BAR; PG8_SCHED;
            PG8_LDB(B0, 1, 0); PG8_LDB(B1, 1, 1); PG8_SCHED; PG8_LDA(At, 1, 0); PG8_STAGE(PG8_SA(0, 1), a2 + hstep, voffA);
            PG8_WAIT_V(8); PG8_WAIT_L(0); PG8_BAR; PG8_MMA(0, 0, At, B0); PG8_MMA(0, 1, At, B1); PG8_BAR; PG8_SCHED;
            PG8_LDA(At, 1, 1); PG8_STAGE(PG8_SB(1, 0), b3, voffB); PG8_STAGE(PG8_SB(1, 1), b3 + hstep, voffB); PG8_STAGE(PG8_SA(1, 0), a3, voffA);
            PG8_WAIT_V(8); PG8_WAIT_L(0); PG8_BAR; PG8_MMA(1, 0, At, B0); PG8_MMA(1, 1, At, B1); PG8_BAR; PG8_SCHED;
            } else {
            PG8_LDB(B0, 0, 0); PG8_SCHED; PG8_LDA(At, 0, 0); PG8_STAGE(PG8_SA(1, 1), a1 + hstep, voffA);
            PG8_WAIT_L(8); PG8_BAR; PG8_WAIT_L(0); PG8_MMA(0, 0, At, B0); PG8_BAR; PG8_SCHED;
            PG8_LDB(B1, 0, 1); PG8_STAGE(PG8_SB(0, 0), b2, voffB);
            PG8_BAR; PG8_WAIT_L(0); PG8_MMA(0, 1, At, B1); PG8_BAR;
            PG8_LDA(At, 0, 1); PG8_STAGE(PG8_SA(0, 0), a2, voffA);
            PG8_BAR; PG8_WAIT_L(0); PG8_MMA(1, 0, At, B0); PG8_BAR; PG8_SCHED;
            PG8_STAGE(PG8_SB(0, 1), b2 + hstep, voffB);
            PG8_WAIT_V(6); PG8_BAR; PG8_MMA(1, 1, At, B1); PG8_BAR;
            PG8_LDB(B0, 1, 0); PG8_SCHED; PG8_LDA(At, 1, 0); PG8_STAGE(PG8_SA(0, 1), a2 + hstep, voffA);
            PG8_WAIT_L(8); PG8_BAR; PG8_WAIT_L(0); PG8_MMA(0, 0, At, B0); PG8_BAR; PG8_SCHED;
            PG8_LDB(B1, 1, 1); PG8_STAGE(PG8_SB(1, 0), b3, voffB);
            PG8_BAR; PG8_WAIT_L(0); PG8_MMA(0, 1, At, B1); PG8_BAR;
            PG8_LDA(At, 1, 1); PG8_STAGE(PG8_SA(1, 0), a3, voffA);
            PG8_BAR; PG8_WAIT_L(0); PG8_MMA(1, 0, At, B0); PG8_BAR; PG8_SCHED;
            PG8_STAGE(PG8_SB(1, 1), b3 + hstep, voffB);
            PG8_WAIT_V(6); PG8_BAR; PG8_MMA(1, 1, At, B1); PG8_BAR;
            }
        }
        if constexpr (ALIGN_EPI) { if (wr == 0) PG8_BAR; }
        if constexpr (!Epi::AFTER_DRAIN) { E(acc, cur, wr, wc, fr, fq); S.done(cur); }
        if (!has_next) break;
#pragma unroll
        for (int a = 0; a < 2; ++a)
#pragma unroll
            for (int b = 0; b < 2; ++b)
#pragma unroll
                for (int m = 0; m < 4; ++m)
#pragma unroll
                    for (int n = 0; n < 2; ++n) acc[a][b][m][n] = (f32x4){0.f, 0.f, 0.f, 0.f};
        cur = nxt; cA = nA; cB = nB; ++ui;
        if constexpr (ALIGN_EPI) { if (wr == 1) PG8_BAR; }
    }
    PG8_WAIT_V(0);
    if constexpr (!ALIGN_EPI) { if (wr == 0) PG8_BAR; }
    PG8_BAR;
    if constexpr (Epi::AFTER_DRAIN) { E.fused(acc, cur, wr, wc, fr, fq, lds, wid, lane); S.done(cur); }
#undef PG8_SA
#undef PG8_SB
#undef PG8_STAGE
#undef PG8_LDA
#undef PG8_LDB
#undef PG8_MMA
#undef PG8_WAIT_V
#undef PG8_WAIT_L
#undef PG8_BAR
#undef PG8_SCHED
}
}

#define LAS __attribute__((address_space(3)))
typedef unsigned short bf16;
using pg8::bf16x8; using pg8::f32x4; using pg8::u32x4;
typedef unsigned u32x2 __attribute__((ext_vector_type(2)));
typedef float f32x2v __attribute__((ext_vector_type(2)));
constexpr int TP = 65536, TS = 512, TT = TP + TS;
constexpr int DM = 1024, NL = 4, NIN = 3584, DFF = 4096;
constexpr float EPS = 1e-6f;
constexpr int NITEM = 4128;
constexpr size_t O_Y = 0, O_KP = (size_t)TT * DM, O_VP = O_KP + (size_t)NL * TP * 512, O_GP = O_VP + (size_t)NL * TP * 512, O_CP = O_GP + (size_t)NL * 16 * 4 * 16384,
    O_MKP = O_CP + (size_t)NL * 16 * 3 * 1536, O_MVP = O_MKP + (size_t)NL * 4096 * 1024, O_KS = O_MVP + (size_t)NL * 4096 * 1024, O_VS = O_KS + (size_t)NL * TS * 512,
    O_GS = O_VS + (size_t)NL * TS * 512, O_CS = O_GS + (size_t)NL * 8 * 4 * 16384, O_END = O_CS + (size_t)NL * 8 * 3 * 1536;
static_assert(O_END == 378454016ull, "output size");
constexpr size_t al(size_t x) { return (x + 4095) & ~(size_t)4095; }
constexpr size_t W_WIN = 0, W_WOUT = al(W_WIN + (size_t)NL * NIN * DM * 2), W_WQ = al(W_WOUT + (size_t)NL * DM * DM * 2), W_WO = al(W_WQ + (size_t)NL * DM * DM * 2),
    W_WKV = al(W_WO + (size_t)NL * DM * DM * 2), W_W1 = al(W_WKV + (size_t)NL * 2048 * DM * 2), W_W2 = al(W_W1 + (size_t)NL * DFF * DM * 2), W_WAB = al(W_W2 + (size_t)NL * DFF * DM * 2),
    W_HB = al(W_WAB + (size_t)NL * 8 * DM * 4), W_SSQ = al(W_HB + (size_t)TT * DM * 2), W_PROJ = al(W_SSQ + (size_t)TT * 16 * 4), W_PVT = al(W_PROJ + (size_t)6 * TT * 512 * 2),
    W_SVT = al(W_PVT + (size_t)64 * 128 * 4096 * 2), W_SK = al(W_SVT + (size_t)NL * 32 * 128 * 2112 * 2), W_UT = al(W_SK + (size_t)NL * 8 * 2112 * 512 * 2),
    W_WM = al(W_UT + (size_t)NITEM * 8192 * 2), W_QG = al(W_WM + (size_t)NITEM * 8192 * 2), W_KDT = al(W_QG + (size_t)NITEM * 8192 * 2), W_QK = al(W_KDT + (size_t)NITEM * 8192 * 2),
    W_GL = al(W_QK + (size_t)NITEM * 4096 * 2), W_MIX = al(W_GL + (size_t)NITEM * 4), W_QM = al(W_MIX + (size_t)TT * DM * 2), W_MA = al(W_QM + (size_t)TT * DM * 2),
    W_FH = al(W_MA + (size_t)TT * DM * 2), W_MEMB = al(W_FH + (size_t)TT * DFF * 2), W_RINVM = al(W_MEMB + (size_t)4096 * DM * 2), W_MKB = al(W_RINVM + 4096 * 4),
    W_MVT = al(W_MKB + (size_t)NL * 4096 * DM * 2), W_CMK = al(W_MVT + (size_t)NL * 4096 * DM * 2), W_CMVT = al(W_CMK + (size_t)NL * 2048 * DM * 2), W_CTL = al(W_CMVT + (size_t)NL * 2048 * DM * 2), W_END = W_CTL + 16384;
constexpr size_t CTL_BYTES = 16384;
constexpr int LDS_BYTES = 147456;

struct Params { const float* in[31]; float* out; unsigned char* ws; };
constexpr int LDS_PARAMS = LDS_BYTES - 512;
struct LP { volatile __attribute__((address_space(3))) const unsigned* base;
    __device__ __forceinline__ unsigned long long raw(int i) const { unsigned off = 8u * (unsigned)i; asm volatile("" : "+v"(off));
        volatile __attribute__((address_space(3))) const unsigned* q = (volatile __attribute__((address_space(3))) const unsigned*)((volatile __attribute__((address_space(3))) const unsigned char*)base + off);
        unsigned lo = q[0], hi = q[1]; lo = __builtin_amdgcn_readfirstlane(lo); hi = __builtin_amdgcn_readfirstlane(hi); return ((unsigned long long)hi << 32) | lo; }
    __device__ __forceinline__ const float* in(int i) const { return (const float*)(const __attribute__((address_space(1))) float*)raw(i); }
    __device__ __forceinline__ float* out() const { return (float*)(__attribute__((address_space(1))) float*)raw(31); }
    __device__ __forceinline__ unsigned char* ws() const { return (unsigned char*)(__attribute__((address_space(1))) unsigned char*)raw(32); } };
enum { I_XP = 0, I_XS, I_MEM, I_CDK, I_CDV, I_CMK, I_CMV, I_SG, I_SGC, I_LNMIX, I_WIN, I_CONVW, I_ALOG, I_DTB, I_GNORM, I_LQ1, I_LK1, I_LQ2, I_LK2, I_DNORM, I_WOUT, I_LNMQ, I_LNMKV,
       I_WMQ, I_WMK, I_WMV, I_WMO, I_LNFFN, I_W1, I_W2, I_LNF };

__device__ __forceinline__ float bf2f(unsigned b) { return __uint_as_float(b << 16); }
typedef float f32x2_t __attribute__((ext_vector_type(2)));
typedef __bf16 bf16x2_t __attribute__((ext_vector_type(2)));
__device__ __forceinline__ unsigned pk2(float lo, float hi) { f32x2_t v = {lo, hi}; bf16x2_t b = __builtin_convertvector(v, bf16x2_t); return __builtin_bit_cast(unsigned, b); }
__device__ __forceinline__ bf16 f2bf(float f) { return (bf16)(pk2(f, 0.f) & 0xffffu); }
template <int CTRL, int ROWMASK> __device__ __forceinline__ float dppf(float oldv, float v) {
    return __builtin_bit_cast(float, __builtin_amdgcn_update_dpp(__builtin_bit_cast(int, oldv), __builtin_bit_cast(int, v), CTRL, ROWMASK, 0xf, false)); }
__device__ __forceinline__ float wave_sum(float v) {
    v += dppf<0xb1, 0xf>(v, v);
    v += dppf<0x4e, 0xf>(v, v);
    v += dppf<0x124, 0xf>(v, v);
    v += dppf<0x128, 0xf>(v, v);
    v += dppf<0x142, 0xa>(0.f, v);
    v += dppf<0x143, 0xc>(0.f, v);
    return __builtin_bit_cast(float, __builtin_amdgcn_readlane(__builtin_bit_cast(int, v), 63));
}
__device__ __forceinline__ f32x4 mfma16(bf16x8 a, bf16x8 b, f32x4 c) { return __builtin_amdgcn_mfma_f32_16x16x32_bf16(a, b, c, 0, 0, 0); }
__device__ __forceinline__ bf16x8 lfrag(const LAS unsigned char* base, int row, int stride, int col) { return *(const LAS bf16x8*)(base + row * stride + col * 2); }
__device__ __forceinline__ bf16x8 gfrag(const bf16* p) { return *(const bf16x8*)p; }
#define LDS_WAIT() asm volatile("s_waitcnt lgkmcnt(0)" ::: "memory")

__device__ __forceinline__ void rinv8(const float* ssq, int row0, int fq, float (&ri)[2][4]) {
#pragma unroll
    for (int ai = 0; ai < 2; ++ai)
#pragma unroll
        for (int m = 0; m < 4; ++m) { const int r = row0 + ai * 128 + m * 16; const f32x4 v = *(const f32x4*)(ssq + (size_t)r * 16 + 4 * fq);
            float s = (v[0] + v[1]) + (v[2] + v[3]); s += __shfl_xor(s, 16); s += __shfl_xor(s, 32); ri[ai][m] = rsqrtf(s * (1.0f / 1024.0f) + EPS); }
}
__device__ __forceinline__ float rinv1(const float* ssq, int r, int fq) {
    const f32x4 v = *(const f32x4*)(ssq + (size_t)r * 16 + 4 * fq); float s = (v[0] + v[1]) + (v[2] + v[3]); s += __shfl_xor(s, 16); s += __shfl_xor(s, 32); return rsqrtf(s * (1.0f / 1024.0f) + EPS); }
#define EPI_FENCE() do { } while (0)
__device__ __forceinline__ u32x4 pack8(const f32x4 a, const f32x4 b) { u32x4 w; w.x = pk2(a[0], a[1]); w.y = pk2(a[2], a[3]); w.z = pk2(b[0], b[1]); w.w = pk2(b[2], b[3]); return w; }

struct EpiIn {
    static constexpr bool PERM = true, AFTER_DRAIN = false;
    const float* ssq; bf16* proj; bf16* pvt; bf16* svt_l; bf16* sk_l; float* okp_l; float* ovp_l; float* oks_l; float* ovs_l;
    __device__ __forceinline__ void operator()(const f32x4 (&acc)[2][2][4][2], const pg8::Unit& u, int wr, int wc, int fr, int fq) const {
        const int row0 = u.pm * 256 + wr * 64 + fr; float ri[2][4]; rinv8(ssq, row0, fq, ri);
        const int tsr = u.pn >> 1, colt0 = (u.pn & 1) * 256 + wc * 32 + 8 * fq; const bool prompt = u.pm < 256;
#pragma unroll
        for (int ai = 0; ai < 2; ++ai)
#pragma unroll
            for (int m = 0; m < 4; ++m) { const int r = row0 + ai * 128 + m * 16; const float sc = ri[ai][m];
#pragma unroll
                for (int bj = 0; bj < 2; ++bj) { const int c = colt0 + bj * 128; const f32x4 v0 = acc[ai][bj][m][0] * sc, v1 = acc[ai][bj][m][1] * sc;
                    if (tsr < 6) *(u32x4*)(proj + (size_t)tsr * TT * 512 + (size_t)r * 512 + c) = pack8(v0, v1);
                    if (tsr >= 5) { float* dst = prompt ? ((tsr == 5 ? okp_l : ovp_l) + (size_t)r * 512 + c) : ((tsr == 5 ? oks_l : ovs_l) + (size_t)(r - TP) * 512 + c);
                        *(f32x4*)dst = v0; *(f32x4*)(dst + 4) = v1; }
                    if (tsr == 5 && !prompt) { const int rs = r - TP, b = rs >> 6, t = rs & 63; *(u32x4*)(sk_l + ((size_t)b * 2112 + 2048 + t) * 512 + c) = pack8(v0, v1); }
                    if (tsr == 6) { const int hh = c >> 7, e0 = c & 127; bf16* base; size_t st;
                        if (prompt) { const int b = r >> 12, t = r & 4095; base = pvt + ((size_t)(b * 4 + hh) * 128 + e0) * 4096 + t; st = 4096; }
                        else { const int rs = r - TP, b = rs >> 6, t = rs & 63; base = svt_l + ((size_t)(b * 4 + hh) * 128 + e0) * 2112 + 2048 + t; st = 2112; }
#pragma unroll
                        for (int j = 0; j < 4; ++j) { base[(size_t)j * st] = f2bf(v0[j]); base[(size_t)(j + 4) * st] = f2bf(v1[j]); } }
                } EPI_FENCE(); }
    }
};
struct EpiRes {
    static constexpr bool PERM = true, AFTER_DRAIN = false;
    float* H; bf16* hb; float* ssq;
    __device__ __forceinline__ void operator()(const f32x4 (&acc)[2][2][4][2], const pg8::Unit& u, int wr, int wc, int fr, int fq) const {
        const int row0 = u.pm * 256 + wr * 64 + fr, col0 = u.pn * 256 + wc * 32 + 8 * fq;
#pragma unroll
        for (int ai = 0; ai < 2; ++ai)
#pragma unroll
            for (int m = 0; m < 4; ++m) { const int r = row0 + ai * 128 + m * 16; float ss = 0.f;
#pragma unroll
                for (int bj = 0; bj < 2; ++bj) { bf16* hp = hb + (size_t)r * DM + col0 + bj * 128; const u32x4 hv = *(const u32x4*)hp;
                    f32x4 v0, v1; v0[0] = bf2f(hv.x & 0xffffu); v0[1] = bf2f(hv.x >> 16); v0[2] = bf2f(hv.y & 0xffffu); v0[3] = bf2f(hv.y >> 16); v1[0] = bf2f(hv.z & 0xffffu); v1[1] = bf2f(hv.z >> 16); v1[2] = bf2f(hv.w & 0xffffu); v1[3] = bf2f(hv.w >> 16);
                    v0 += acc[ai][bj][m][0]; v1 += acc[ai][bj][m][1];
                    *(u32x4*)hp = pack8(v0, v1);
                    ss += (v0[0] * v0[0] + v0[1] * v0[1]) + (v0[2] * v0[2] + v0[3] * v0[3]) + (v1[0] * v1[0] + v1[1] * v1[1]) + (v1[2] * v1[2] + v1[3] * v1[3]); }
                ss += __shfl_xor(ss, 16); ss += __shfl_xor(ss, 32);
                if (fq == 0) ssq[(size_t)r * 16 + u.pn * 4 + wc] = ss; EPI_FENCE(); }
    }
};
template <int ACT> struct EpiRow {
    static constexpr bool PERM = true, AFTER_DRAIN = false;
    const float* ssq; bf16* O; int ldc;
    __device__ __forceinline__ void operator()(const f32x4 (&acc)[2][2][4][2], const pg8::Unit& u, int wr, int wc, int fr, int fq) const {
        const int row0 = u.pm * 256 + wr * 64 + fr, col0 = u.pn * 256 + wc * 32 + 8 * fq; float ri[2][4]; rinv8(ssq, row0, fq, ri);
#pragma unroll
        for (int ai = 0; ai < 2; ++ai)
#pragma unroll
            for (int m = 0; m < 4; ++m) { const int r = row0 + ai * 128 + m * 16; const float sc = ri[ai][m];
#pragma unroll
                for (int bj = 0; bj < 2; ++bj) { f32x4 v0 = acc[ai][bj][m][0] * sc, v1 = acc[ai][bj][m][1] * sc;
                    if (ACT == 1) {
#pragma unroll
                        for (int j = 0; j < 4; ++j) { const float a = fmaxf(v0[j], 0.f), b = fmaxf(v1[j], 0.f); v0[j] = a * a; v1[j] = b * b; } }
                    *(u32x4*)(O + (size_t)r * ldc + col0 + bj * 128) = pack8(v0, v1); } EPI_FENCE(); }
    }
};
struct EpiMemKV {
    static constexpr bool PERM = true, AFTER_DRAIN = false;
    const float* rinvm; float* omk; float* omv; bf16* mkb; bf16* mvt;
    __device__ __forceinline__ void operator()(const f32x4 (&acc)[2][2][4][2], const pg8::Unit& u, int wr, int wc, int fr, int fq) const {
        const int row0 = u.pm * 256 + wr * 64 + fr, l = u.pn >> 3, kv = (u.pn >> 2) & 1, col0 = (u.pn & 3) * 256 + wc * 32 + 8 * fq;
#pragma unroll
        for (int ai = 0; ai < 2; ++ai)
#pragma unroll
            for (int m = 0; m < 4; ++m) { const int r = row0 + ai * 128 + m * 16; const float sc = rinvm[r];
#pragma unroll
                for (int bj = 0; bj < 2; ++bj) { const int c = col0 + bj * 128; const f32x4 v0 = acc[ai][bj][m][0] * sc, v1 = acc[ai][bj][m][1] * sc;
                    float* dst = (kv ? omv : omk) + ((size_t)l * 4096 + r) * 1024 + c; *(f32x4*)dst = v0; *(f32x4*)(dst + 4) = v1;
                    if (!kv) *(u32x4*)(mkb + ((size_t)l * 4096 + r) * 1024 + c) = pack8(v0, v1);
                    else { const int hh = c >> 8, e0 = c & 255, b = r >> 8, mm = r & 255; bf16* base = mvt + ((((size_t)l * 16 + b) * 4 + hh) * 256 + e0) * 256 + mm;
#pragma unroll
                        for (int j = 0; j < 4; ++j) { base[(size_t)j * 256] = f2bf(v0[j]); base[(size_t)(j + 4) * 256] = f2bf(v1[j]); } } } EPI_FENCE(); }
    }
};
#define XB_TMO      128
#define XB_XCNT(j)  (256  + 64 * (j))
#define XB_XSUB(j)  (1280 + 64 * (j))
#define XB_XGEN(j)  (2304 + 64 * (j))
#define XB_TOP      3328
#define XB_TOPGEN   3392
#define XCD_BAR_WORDS 3456
#define XB_SPIN_CAP (1u << 18)

__device__ __forceinline__ unsigned xb_ld(unsigned* p)              { return __hip_atomic_load(p, __ATOMIC_RELAXED, __HIP_MEMORY_SCOPE_AGENT); }
__device__ __forceinline__ unsigned xb_add(unsigned* p, unsigned v) { return __hip_atomic_fetch_add(p, v, __ATOMIC_RELAXED, __HIP_MEMORY_SCOPE_AGENT); }
__device__ __forceinline__ unsigned xb_xcc_id() { return (unsigned)__builtin_amdgcn_s_getreg((3 << 11) | 20) & 0xFu; }
#define XB_SPIN(cond, bar) do { unsigned _sp = 0; while (cond) { __builtin_amdgcn_s_sleep(1); \
    if ((++_sp & 255u) == 0u) { if (xb_ld(&(bar)[XB_TMO])) break; if (_sp > XB_SPIN_CAP) { atomicAdd(&(bar)[XB_TMO], 1u); break; } } } } while (0)

struct XcdBarrier {
    unsigned* bar; unsigned x;
    volatile LAS unsigned* st;
};

__device__ __forceinline__ XcdBarrier xcd_barrier_post(unsigned* bar, volatile LAS unsigned* st) {
    XcdBarrier b; b.bar = bar; b.x = xb_xcc_id(); b.st = st;
    if (threadIdx.x == 0) (void)xb_add(&bar[XB_XCNT(b.x)], 1u);
    return b;
}
__device__ __forceinline__ void xcd_barrier_complete(unsigned* bar, unsigned x, unsigned& nloc, unsigned& nx) {
    const unsigned G = gridDim.x * gridDim.y * gridDim.z;
    unsigned sum, cnt, mine, sp = 0u;
    for (;;) {
        sum = 0u; cnt = 0u; mine = 0u;
#pragma unroll
        for (unsigned j = 0; j < 16; ++j) { const unsigned c = xb_ld(&bar[XB_XCNT(j)]); sum += c; cnt += (c > 0u) ? 1u : 0u; mine = (j == x) ? c : mine; }
        if (sum == G) break;
        __builtin_amdgcn_s_sleep(1);
        if ((++sp & 255u) == 0u) { if (xb_ld(&bar[XB_TMO])) break; if (sp > XB_SPIN_CAP) { atomicAdd(&bar[XB_TMO], 1u); break; } }
    }
    nloc = mine > 0u ? mine : 1u; nx = cnt > 0u ? cnt : 1u;
}

__device__ __forceinline__ void xcd_barrier(const XcdBarrier& b) {
    asm volatile("s_waitcnt vmcnt(0)" ::: "memory");
    __syncthreads();
    if (threadIdx.x == 0) {
        unsigned* bar = b.bar;
        __builtin_amdgcn_s_waitcnt(0);
        unsigned nloc = b.st[0], nx = b.st[1];
        if (nloc == 0u) { xcd_barrier_complete(bar, b.x, nloc, nx); b.st[0] = nloc; b.st[1] = nx; }
        const unsigned old = xb_add(&bar[XB_XSUB(b.x)], 1u);
        const unsigned gen = old / nloc;
        if (old + 1u == (gen + 1u) * nloc) {
            __builtin_amdgcn_fence(__ATOMIC_RELEASE, "agent");
            asm volatile("s_waitcnt vmcnt(0)" ::: "memory");
            const unsigned og = xb_add(&bar[XB_TOP], 1u);
            const unsigned tg = og / nx;
            if (og + 1u == (tg + 1u) * nx) xb_add(&bar[XB_TOPGEN], 1u);
            else XB_SPIN(xb_ld(&bar[XB_TOPGEN]) == tg, bar);
            __builtin_amdgcn_fence(__ATOMIC_ACQUIRE, "agent");
            xb_add(&bar[XB_XGEN(b.x)], 1u);
            asm volatile("s_waitcnt vmcnt(0)" ::: "memory");
        } else {
            XB_SPIN(xb_ld(&bar[XB_XGEN(b.x)]) == gen, bar);
            __builtin_amdgcn_fence(__ATOMIC_ACQUIRE, "agent");
            asm volatile("s_waitcnt vmcnt(0)" ::: "memory");
        }
    }
    __syncthreads();
}

__device__ __forceinline__ void tr_item(const float* src, int ld_src, const float* gain, bf16* dst, int ld_dst, int k0, int n0s, int n0d, LAS float* scr, int lane) {
#pragma unroll 8
    for (int i = 0; i < 32; ++i) { const int kk = 2 * i + (lane >> 5); float v = src[(size_t)(k0 + kk) * ld_src + n0s + (lane & 31)]; if (gain) v *= gain[k0 + kk]; scr[kk * 33 + (lane & 31)] = v; }
    LDS_WAIT(); asm volatile("" ::: "memory");
    const int c = lane & 7;
#pragma unroll
    for (int j = 0; j < 4; ++j) { const int n = (lane >> 3) + 8 * j; const LAS float* s = scr + (8 * c) * 33 + n;
        u32x4 o; o.x = pk2(s[0 * 33], s[1 * 33]); o.y = pk2(s[2 * 33], s[3 * 33]); o.z = pk2(s[4 * 33], s[5 * 33]); o.w = pk2(s[6 * 33], s[7 * 33]);
        *(u32x4*)(dst + (size_t)(n0d + n) * ld_dst + k0 + 8 * c) = o; }
    LDS_WAIT(); asm volatile("" ::: "memory");
}
__device__ __forceinline__ float row_cvt(const float* xrow, bf16* orow, float* crow, int lane) {
    const f32x4* xr = (const f32x4*)xrow + lane; f32x4 v[4]; float s = 0.f;
#pragma unroll
    for (int j = 0; j < 4; ++j) { v[j] = xr[64 * j]; s += (v[j][0] * v[j][0] + v[j][1] * v[j][1]) + (v[j][2] * v[j][2] + v[j][3] * v[j][3]); }
    u32x2* o8 = (u32x2*)orow + lane;
#pragma unroll
    for (int j = 0; j < 4; ++j) { u32x2 w; w.x = pk2(v[j][0], v[j][1]); w.y = pk2(v[j][2], v[j][3]); o8[64 * j] = w; if (crow) ((f32x4*)crow + lane)[64 * j] = v[j]; }
    return wave_sum(s);
}
__device__ __forceinline__ void phase0(const LP P, LAS unsigned char* lds) {
    const int tid = opaque_tid(), lane = tid & 63, wave = tid >> 6; unsigned char* ws = P.ws();
    LAS float* scr = (LAS float*)(lds + wave * 16384);
    const int gw = blockIdx.x * 8 + wave, NGW = gridDim.x * 8;
    constexpr int PER_L = 1792 + 512 * 5 + 2048 * 2, NW_ITEMS = PER_L * NL, N_CDV = 128 * 128, N_CMV = 128 * 32, N_TR = NW_ITEMS + N_CDV + N_CMV;
    for (int it = gw; it < N_TR; it += NGW) {
        if (it < NW_ITEMS) { const int l = it / PER_L; int r = it % PER_L;
            if (r < 1792) { const int kb = r / 112, nb = r % 112, n0 = nb * 32; tr_item(P.in(I_WIN) + (size_t)l * 1024 * 3592, 3592, P.in(I_LNMIX) + l * 1024, (bf16*)(ws + W_WIN) + (size_t)l * NIN * DM, DM, kb * 64, n0 + (n0 >= 2048 ? 8 : 0), n0, scr, lane); continue; } r -= 1792;
            if (r < 512) { tr_item(P.in(I_WOUT) + (size_t)l * DM * DM, DM, nullptr, (bf16*)(ws + W_WOUT) + (size_t)l * DM * DM, DM, (r >> 5) * 64, (r & 31) * 32, (r & 31) * 32, scr, lane); continue; } r -= 512;
            if (r < 512) { tr_item(P.in(I_WMQ) + (size_t)l * DM * DM, DM, P.in(I_LNMQ) + l * 1024, (bf16*)(ws + W_WQ) + (size_t)l * DM * DM, DM, (r >> 5) * 64, (r & 31) * 32, (r & 31) * 32, scr, lane); continue; } r -= 512;
            if (r < 512) { tr_item(P.in(I_WMK) + (size_t)l * DM * DM, DM, P.in(I_LNMKV) + l * 1024, (bf16*)(ws + W_WKV) + (size_t)l * 2048 * DM, DM, (r >> 5) * 64, (r & 31) * 32, (r & 31) * 32, scr, lane); continue; } r -= 512;
            if (r < 512) { tr_item(P.in(I_WMV) + (size_t)l * DM * DM, DM, P.in(I_LNMKV) + l * 1024, (bf16*)(ws + W_WKV) + (size_t)l * 2048 * DM, DM, (r >> 5) * 64, (r & 31) * 32, 1024 + (r & 31) * 32, scr, lane); continue; } r -= 512;
            if (r < 512) { tr_item(P.in(I_WMO) + (size_t)l * DM * DM, DM, nullptr, (bf16*)(ws + W_WO) + (size_t)l * DM * DM, DM, (r >> 5) * 64, (r & 31) * 32, (r & 31) * 32, scr, lane); continue; } r -= 512;
            if (r < 2048) { tr_item(P.in(I_W1) + (size_t)l * DM * DFF, DFF, P.in(I_LNFFN) + l * 1024, (bf16*)(ws + W_W1) + (size_t)l * DFF * DM, DM, (r >> 7) * 64, (r & 127) * 32, (r & 127) * 32, scr, lane); continue; } r -= 2048;
            tr_item(P.in(I_W2) + (size_t)l * DFF * DM, DM, nullptr, (bf16*)(ws + W_W2) + (size_t)l * DM * DFF, DFF, (r >> 5) * 64, (r & 31) * 32, (r & 31) * 32, scr, lane);
        } else if (it < NW_ITEMS + N_CDV) { const int r = it - NW_ITEMS, lbh = r >> 7, q = r & 127, l = lbh >> 5, b = (lbh >> 2) & 7, h = lbh & 3;
            tr_item(P.in(I_CDV) + ((size_t)(l * 8 + b) * 2048) * 512 + h * 128, 512, nullptr, (bf16*)(ws + W_SVT) + ((size_t)(l * 32 + b * 4 + h) * 128) * 2112, 2112, (q >> 2) * 64, (q & 3) * 32, (q & 3) * 32, scr, lane);
        } else { const int r = it - NW_ITEMS - N_CDV, lbh = r >> 5, q = r & 31, l = lbh >> 5, b = (lbh >> 2) & 7, h = lbh & 3;
            tr_item(P.in(I_CMV) + ((size_t)(l * 8 + b) * 256) * 1024 + h * 256, 1024, nullptr, (bf16*)(ws + W_CMVT) + ((size_t)((l * 8 + b) * 4 + h) * 256) * 256, 256, (q >> 3) * 64, (q & 7) * 32, (q & 7) * 32, scr, lane);
        }
    }
    float* H = P.out() + O_Y; bf16* HB = (bf16*)(ws + W_HB); float* SSQ = (float*)(ws + W_SSQ);
    for (int m = gw; m < TT; m += NGW) { const float* src = m < TP ? P.in(I_XP) + (size_t)m * DM : P.in(I_XS) + (size_t)(m - TP) * DM;
        const float s = row_cvt(src, HB + (size_t)m * DM, nullptr, lane); if (lane < 16) SSQ[(size_t)m * 16 + lane] = lane == 0 ? s : 0.f; }
    for (int m = gw; m < 4096; m += NGW) { const float s = row_cvt(P.in(I_MEM) + (size_t)m * DM, (bf16*)(ws + W_MEMB) + (size_t)m * DM, nullptr, lane); if (lane == 0) ((float*)(ws + W_RINVM))[m] = rsqrtf(s * (1.0f / 1024.0f) + EPS); }
    for (int m = gw; m < NL * 2048; m += NGW) row_cvt(P.in(I_CMK) + (size_t)m * DM, (bf16*)(ws + W_CMK) + (size_t)m * DM, nullptr, lane);
    for (int m = gw; m < NL * 8 * 1024; m += NGW) {
        const int lb = m >> 10, pr = (m & 1023) * 2; row_cvt(P.in(I_CDK) + ((size_t)lb * 2048 + pr) * 512, (bf16*)(ws + W_SK) + ((size_t)lb * 2112 + pr) * 512, nullptr, lane); }
    for (int i = blockIdx.x * 512 + tid; i < NL * 8 * 1024; i += gridDim.x * 512) { const int l = i >> 13, j = (i >> 10) & 7, k = i & 1023;
        ((float*)(ws + W_WAB))[i] = P.in(I_LNMIX)[l * 1024 + k] * P.in(I_WIN)[((size_t)l * 1024 + k) * 3592 + 2048 + j]; }
}

#ifndef G1_UNROLL
#define G1_UNROLL 8
#endif
constexpr int G1_QB = 0, G1_KB = 18432, G1_VBT = 36864, G1_KGT = 57344, G1_AM = 77824, G1_AB16 = 95232, G1_TT = 105472, G1_TB = 115712, G1_RT = 125952, G1_GS = 129024, G1_BT = 129280, G1_GC = 129536;
template <bool SAMPLE>
__device__ __forceinline__ void g1_pass1(const LP P, int l, int h, int cidx, int tok0, bool first, int sb, LAS unsigned char* lds, int lane, int w) {
    unsigned char* ws = P.ws(); const bf16* PROJ = (const bf16*)(ws + W_PROJ); const bf16* HB = (const bf16*)(ws + W_HB); const float* SSQ = (const float*)(ws + W_SSQ);
    LAS float* gs = (LAS float*)(lds + G1_GS); LAS float* bt = (LAS float*)(lds + G1_BT);
    float wa[16], wb[16];
    { const float* pa = (const float*)(ws + W_WAB) + ((size_t)l * 8 + h) * 1024 + 16 * lane; const float* pb = pa + 4 * 1024;
#pragma unroll
      for (int j = 0; j < 4; ++j) { const f32x4 a = *(const f32x4*)(pa + 4 * j), b = *(const f32x4*)(pb + 4 * j);
#pragma unroll
          for (int k = 0; k < 4; ++k) { wa[4 * j + k] = a[k]; wb[4 * j + k] = b[k]; } } }
    float cw[3][4][2];
    { const float* convw = P.in(I_CONVW);
#pragma unroll
    for (int wh = 0; wh < 3; ++wh)
#pragma unroll
        for (int j = 0; j < 4; ++j) { const f32x2v t2 = *(const f32x2v*)(convw + ((size_t)l * 4 + j) * 1536 + wh * 512 + h * 128 + 2 * lane); cw[wh][j][0] = t2[0]; cw[wh][j][1] = t2[1]; } }
    const float na = -__expf(P.in(I_ALOG)[l * 4 + h]), dtb = P.in(I_DTB)[l * 4 + h];
    const float* sgc = SAMPLE ? P.in(I_SGC) : nullptr;
    const float fz = first ? 0.f : 1.f;
#pragma unroll G1_UNROLL
    for (int tt = 0; tt < 8; ++tt) { const int t = 8 * w + tt, tok = tok0 + t;
        float sv[3][2];
#pragma unroll
        for (int wh = 0; wh < 3; ++wh) { float y0 = 0.f, y1 = 0.f;
#pragma unroll
            for (int j = 0; j < 4; ++j) { const int rr = t - 3 + j; float x0, x1;
                if (!SAMPLE) { const int row = (first && rr < 0) ? 0 : rr; const unsigned u = *(const unsigned*)(PROJ + (size_t)wh * TT * 512 + (size_t)(tok0 + row) * 512 + h * 128 + 2 * lane);
                    const float m = rr < 0 ? fz : 1.f; x0 = bf2f(u & 0xffffu) * m; x1 = bf2f(u >> 16) * m; }
                else { if (rr >= 0) { const unsigned u = *(const unsigned*)(PROJ + (size_t)wh * TT * 512 + (size_t)(tok0 + rr) * 512 + h * 128 + 2 * lane); x0 = bf2f(u & 0xffffu); x1 = bf2f(u >> 16); }
                    else { const f32x2v t2 = *(const f32x2v*)(sgc + ((size_t)(l * 8 + sb) * 3 + (3 + rr)) * 1536 + wh * 512 + h * 128 + 2 * lane); x0 = t2[0]; x1 = t2[1]; } }
                y0 += cw[wh][j][0] * x0; y1 += cw[wh][j][1] * x1; }
            sv[wh][0] = y0 / (1.f + __expf(-y0)); sv[wh][1] = y1 / (1.f + __expf(-y1)); }
        const float qs = rsqrtf(wave_sum(sv[0][0] * sv[0][0] + sv[0][1] * sv[0][1]) + EPS) * 0.08838834764831845f;
        const float ks = rsqrtf(wave_sum(sv[1][0] * sv[1][0] + sv[1][1] * sv[1][1]) + EPS);
        *(LAS unsigned*)(lds + G1_QB + t * 288 + lane * 4) = pk2(sv[0][0] * qs, sv[0][1] * qs);
        *(LAS unsigned*)(lds + G1_KB + t * 288 + lane * 4) = pk2(sv[1][0] * ks, sv[1][1] * ks);
        const u32x4 h0 = *(const u32x4*)(HB + (size_t)tok * DM + 16 * lane), h1 = *(const u32x4*)(HB + (size_t)tok * DM + 16 * lane + 8);
        float da = 0.f, db = 0.f;
#pragma unroll
        for (int k = 0; k < 4; ++k) { const float x0 = bf2f(h0[k] & 0xffffu), x1 = bf2f(h0[k] >> 16), x2 = bf2f(h1[k] & 0xffffu), x3 = bf2f(h1[k] >> 16);
            da += x0 * wa[2 * k] + x1 * wa[2 * k + 1] + x2 * wa[8 + 2 * k] + x3 * wa[8 + 2 * k + 1]; db += x0 * wb[2 * k] + x1 * wb[2 * k + 1] + x2 * wb[8 + 2 * k] + x3 * wb[8 + 2 * k + 1]; }
        da = wave_sum(da); db = wave_sum(db);
        const float sq = wave_sum(lane < 16 ? SSQ[(size_t)tok * 16 + lane] : 0.f), rinv = rsqrtf(sq * (1.0f / 1024.0f) + EPS);
        const float xa = da * rinv + dtb, xb = db * rinv;
        const float sp = fmaxf(xa, 0.f) + log1pf(__expf(-fabsf(xa))), gt = na * sp, beta = 1.f / (1.f + __expf(-xb));
        *(LAS bf16*)(lds + G1_VBT + (2 * lane) * 160 + t * 2) = f2bf(beta * sv[2][0]); *(LAS bf16*)(lds + G1_VBT + (2 * lane + 1) * 160 + t * 2) = f2bf(beta * sv[2][1]);
        if (lane == 0) { gs[t] = gt; bt[t] = beta; }
    }
    if (SAMPLE || (cidx & 63) == 63) { float* outp = P.out();
        float* dst = SAMPLE ? outp + O_CS + ((size_t)(l * 8 + sb) * 3) * 1536 : outp + O_CP + ((size_t)(l * 16 + (cidx >> 6)) * 3) * 1536;
        if (w < 3) {
#pragma unroll
            for (int wh = 0; wh < 3; ++wh) { const unsigned u = *(const unsigned*)(PROJ + (size_t)wh * TT * 512 + (size_t)(tok0 + 61 + w) * 512 + h * 128 + 2 * lane);
                f32x2v t2; t2[0] = bf2f(u & 0xffffu); t2[1] = bf2f(u >> 16); *(f32x2v*)(dst + (size_t)w * 1536 + wh * 512 + h * 128 + 2 * lane) = t2; } } }
}

__device__ __forceinline__ void g1_item(const LP P, int l, int item, LAS unsigned char* lds) {
    const int tid = opaque_tid(), lane = tid & 63, w = tid >> 6, r16 = lane & 15, g = lane >> 4; unsigned char* ws = P.ws();
    const int cidx = item >> 2, h = item & 3; const bool prompt = cidx < 1024;
    const int tok0 = prompt ? cidx * 64 : TP + (cidx - 1024) * 64; const bool first = prompt && ((cidx & 63) == 0); const int sb = cidx - 1024;
    const bf16* PROJ = (const bf16*)(ws + W_PROJ); const bf16* HB = (const bf16*)(ws + W_HB); const float* SSQ = (const float*)(ws + W_SSQ);
    LAS float* gs = (LAS float*)(lds + G1_GS); LAS float* bt = (LAS float*)(lds + G1_BT); LAS float* Gc = (LAS float*)(lds + G1_GC);
    LAS float* Am = (LAS float*)(lds + G1_AM);
#ifdef REPEAT_P1
    for (int rp = 0; rp < 2; ++rp) { if (rp) __syncthreads();
#else
    {
#endif
    if (prompt) g1_pass1<false>(P, l, h, cidx, tok0, first, sb, lds, lane, w); else g1_pass1<true>(P, l, h, cidx, tok0, first, sb, lds, lane, w);
    }
    __syncthreads();
    if (w == 0) { float v = gs[lane];
#pragma unroll
        for (int o = 1; o < 64; o <<= 1) { const float n = __shfl_up(v, o); if (lane >= o) v += n; }
        Gc[lane] = v; if (lane == 63) ((float*)(ws + W_GL))[item] = __expf(v); }
    __syncthreads();
    { const int it = w >> 1; bf16* QK = (bf16*)(ws + W_QK) + (size_t)item * 4096;
#pragma unroll
        for (int jj = 0; jj < 2; ++jj) { const int jt = 2 * (w & 1) + jj; f32x4 a1 = {0.f, 0.f, 0.f, 0.f}, a2 = {0.f, 0.f, 0.f, 0.f};
#pragma unroll
            for (int ks = 0; ks < 4; ++ks) { const bf16x8 ki = lfrag(lds + G1_KB, 16 * it + r16, 288, ks * 32 + 8 * g), kj = lfrag(lds + G1_KB, 16 * jt + r16, 288, ks * 32 + 8 * g), qj = lfrag(lds + G1_QB, 16 * jt + r16, 288, ks * 32 + 8 * g);
                a1 = mfma16(ki, kj, a1);
                a2 = mfma16(ki, qj, a2); }
            const int jc = 16 * jt + r16; const float Gj = Gc[jc]; u32x2 o; float v[4];
#pragma unroll
            for (int rg = 0; rg < 4; ++rg) { const int i = 16 * it + 4 * g + rg; const float Gi = Gc[i];
                const float av = (i > jc) ? bt[i] * a1[rg] * __expf(Gi - Gj) : 0.f; Am[i * 68 + jc] = av; *(LAS bf16*)(lds + G1_AB16 + i * 160 + jc * 2) = f2bf(av);
                v[rg] = (jc >= i) ? a2[rg] * __expf(Gj - Gi) : 0.f; }
            o.x = pk2(v[0], v[1]); o.y = pk2(v[2], v[3]); *(u32x2*)(QK + jc * 64 + 16 * it + 4 * g) = o; } }
    __syncthreads();
    if (w == 0) {
        { const u32x4 z4 = {0u, 0u, 0u, 0u};
#pragma unroll
          for (int k = 0; k < 10; ++k) { *(LAS u32x4*)(lds + G1_TB + (k * 64 + lane) * 16) = z4; *(LAS u32x4*)(lds + G1_TT + (k * 64 + lane) * 16) = z4; } }
        LDS_WAIT();
        { const int p = lane >> 4, c = lane & 15; const LAS float* Ab = Am + (16 * p) * 68 + 16 * p; float Tc[16];
#pragma unroll
          for (int i = 0; i < 16; ++i) { float a = (i == c) ? 1.f : 0.f;
#pragma unroll
              for (int j = 0; j < i; ++j) a -= Ab[i * 68 + j] * Tc[j];
              Tc[i] = a; }
#pragma unroll
          for (int i = 0; i < 16; ++i) { const bf16 tb = f2bf(Tc[i]); *(LAS bf16*)(lds + G1_TB + (16 * p + i) * 160 + (16 * p + c) * 2) = tb; *(LAS bf16*)(lds + G1_TT + (16 * p + c) * 160 + (16 * p + i) * 2) = tb; } }
        LDS_WAIT();
        const bf16x8 zf = {0, 0, 0, 0, 0, 0, 0, 0};
#pragma unroll
        for (int p = 1; p < 4; ++p) {
            f32x4 R[3];
#pragma unroll
            for (int nt = 0; nt < p; ++nt) { R[nt] = (f32x4){0.f, 0.f, 0.f, 0.f};
#pragma unroll
                for (int ks = 0; ks < (p + 1) / 2; ++ks) { const bf16x8 af = (ks * 32 + 8 * g < 16 * p) ? lfrag(lds + G1_AB16, 16 * p + r16, 160, ks * 32 + 8 * g) : zf;
                    R[nt] = mfma16(af, lfrag(lds + G1_TT, 16 * nt + r16, 160, ks * 32 + 8 * g), R[nt]); } }
#pragma unroll
            for (int nt = 0; nt < p; ++nt) { u32x2 o; o.x = pk2(-R[nt][0], -R[nt][1]); o.y = pk2(-R[nt][2], -R[nt][3]); *(LAS u32x2*)(lds + G1_RT + (16 * nt + r16) * 48 + 8 * g) = o; }
            LDS_WAIT();
            const bf16x8 tp = (g < 2) ? lfrag(lds + G1_TB, 16 * p + r16, 160, 16 * p + 8 * g) : zf;
#pragma unroll
            for (int nt = 0; nt < p; ++nt) { const bf16x8 rf = (g < 2) ? *(const LAS bf16x8*)(lds + G1_RT + (16 * nt + r16) * 48 + 16 * g) : zf;
                const f32x4 M = mfma16(tp, rf, (f32x4){0.f, 0.f, 0.f, 0.f});
                u32x2 o; o.x = pk2(M[0], M[1]); o.y = pk2(M[2], M[3]); *(LAS u32x2*)(lds + G1_TT + (16 * nt + r16) * 160 + (16 * p + 4 * g) * 2) = o;
#pragma unroll
                for (int rg = 0; rg < 4; ++rg) *(LAS bf16*)(lds + G1_TB + (16 * p + 4 * g + rg) * 160 + (16 * nt + r16) * 2) = f2bf(M[rg]); }
            LDS_WAIT();
        }
    }
    else { bf16* QG = (bf16*)(ws + W_QG) + (size_t)item * 8192; bf16* KDT = (bf16*)(ws + W_KDT) + (size_t)item * 8192; const float Glast = Gc[63];
        for (int idx = tid - 64; idx < 4096; idx += 448) { const int t = idx >> 6, c2 = idx & 63; const unsigned u = *(const LAS unsigned*)(lds + G1_QB + t * 288 + c2 * 4); const float eg = __expf(Gc[t]);
            *(unsigned*)(QG + t * 128 + 2 * c2) = pk2(bf2f(u & 0xffffu) * eg, bf2f(u >> 16) * eg); }
        for (int idx = tid - 64; idx < 8192; idx += 448) { const int c = idx >> 6, t = idx & 63; const float k = bf2f(*(const LAS bf16*)(lds + G1_KB + t * 288 + c * 2)), Gt = Gc[t];
            *(LAS bf16*)(lds + G1_KGT + c * 160 + t * 2) = f2bf(bt[t] * __expf(Gt) * k); KDT[c * 64 + t] = f2bf(k * __expf(Glast - Gt)); } }
    __syncthreads();
    { const int it = w & 3, eh = w >> 2; bf16* UT = (bf16*)(ws + W_UT) + (size_t)item * 8192; bf16* WM = (bf16*)(ws + W_WM) + (size_t)item * 8192;
        bf16x8 tf[2];
#pragma unroll
        for (int ks = 0; ks < 2; ++ks) tf[ks] = lfrag(lds + G1_TB, 16 * it + r16, 160, ks * 32 + 8 * g);
#pragma unroll
        for (int ee = 0; ee < 4; ++ee) { const int et = 4 * eh + ee; f32x4 a1 = {0.f, 0.f, 0.f, 0.f}, a2 = {0.f, 0.f, 0.f, 0.f};
#pragma unroll
            for (int ks = 0; ks < 2; ++ks) { a1 = mfma16(tf[ks], lfrag(lds + G1_VBT, 16 * et + r16, 160, ks * 32 + 8 * g), a1);
                a2 = mfma16(lfrag(lds + G1_KGT, 16 * et + r16, 160, ks * 32 + 8 * g), tf[ks], a2); }
            u32x2 o; o.x = pk2(a1[0], a1[1]); o.y = pk2(a1[2], a1[3]); *(u32x2*)(UT + (16 * et + r16) * 64 + 16 * it + 4 * g) = o;
            o.x = pk2(a2[0], a2[1]); o.y = pk2(a2[2], a2[3]); *(u32x2*)(WM + (16 * it + r16) * 128 + 16 * et + 4 * g) = o; } }
    __syncthreads();
}
#define LDS_BARRIER() asm volatile("s_waitcnt lgkmcnt(0)\n\ts_barrier" ::: "memory")
constexpr int G2_ST0 = 0, G2_ST1 = 36864, G2_VNT = 73728, G2_STAT = 94208;
__device__ __forceinline__ void g2_load_ops(bf16x8 (&o_wf)[4], bf16x8 (&o_qgf)[4], bf16x8 (&o_qkf)[2], bf16x8 (&o_kf)[2], u32x2 (&o_ut)[4], u32x2 (&o_zz)[4], float& o_gl, const bf16* UTb, const bf16* WMb, const bf16* QGb, const bf16* KDTb, const bf16* QKb, const bf16* Z, const float* GL, int item, int tok, int h, int it, int eh, int w, int r16, int g) {
    const bf16* UT = UTb + (size_t)item * 8192; const bf16* WM = WMb + (size_t)item * 8192; const bf16* QG = QGb + (size_t)item * 8192; const bf16* KDT = KDTb + (size_t)item * 8192; const bf16* QK = QKb + (size_t)item * 4096;
#pragma unroll
    for (int ks = 0; ks < 4; ++ks) { o_wf[ks] = gfrag(WM + (16 * it + r16) * 128 + ks * 32 + 8 * g); o_qgf[ks] = gfrag(QG + (16 * it + r16) * 128 + ks * 32 + 8 * g); }
#pragma unroll
    for (int ks = 0; ks < 2; ++ks) { o_qkf[ks] = gfrag(QK + (16 * it + r16) * 64 + ks * 32 + 8 * g); o_kf[ks] = gfrag(KDT + (16 * w + r16) * 64 + ks * 32 + 8 * g); }
#pragma unroll
    for (int ee = 0; ee < 4; ++ee) { const int et = 4 * eh + ee; o_ut[ee] = *(const u32x2*)(UT + (16 * et + r16) * 64 + 16 * it + 4 * g); o_zz[ee] = *(const u32x2*)(Z + (size_t)tok * 512 + h * 128 + 16 * et + 4 * g); }
    (void)o_gl; (void)GL;
}
__device__ __forceinline__ void g2_item(const LP P, int l, int s, LAS unsigned char* lds) {
    const int tid = opaque_tid(), lane = tid & 63, w = tid >> 6, r16 = lane & 15, g = lane >> 4; unsigned char* ws = P.ws();
    const bool prompt = s < 64; const int bh = prompt ? s : s - 64, b = bh >> 2, h = bh & 3;
    const int nch = prompt ? 64 : 1, cidx0 = prompt ? b * 64 : 1024 + b;
    const bf16* UTb = (const bf16*)(ws + W_UT); const bf16* WMb = (const bf16*)(ws + W_WM); const bf16* QGb = (const bf16*)(ws + W_QG); const bf16* KDTb = (const bf16*)(ws + W_KDT);
    const bf16* QKb = (const bf16*)(ws + W_QK); const float* GL = (const float*)(ws + W_GL); const bf16* Z = (const bf16*)(ws + W_PROJ) + (size_t)3 * TT * 512; bf16* MIX = (bf16*)(ws + W_MIX);
    LAS float* stat = (LAS float*)(lds + G2_STAT);
    f32x4 S[8];
    const float* s0 = P.in(I_SG) + ((size_t)(l * 8 + b) * 4 + h) * 16384;
#pragma unroll
    for (int et = 0; et < 8; ++et) {
#pragma unroll
        for (int rg = 0; rg < 4; ++rg) S[et][rg] = prompt ? 0.f : s0[(16 * w + 4 * g + rg) * 128 + 16 * et + r16];
        u32x2 o; o.x = pk2(S[et][0], S[et][1]); o.y = pk2(S[et][2], S[et][3]); *(LAS u32x2*)(lds + G2_ST0 + (16 * et + r16) * 288 + (16 * w + 4 * g) * 2) = o; }
    __syncthreads();
    int cur = G2_ST0, nxt = G2_ST1;
    const int it = w & 3, eh = w >> 2;
    const f32x4 gn0 = *(const f32x4*)(P.in(I_GNORM) + l * 128 + 16 * (4 * eh + 0) + 4 * g), gn1 = *(const f32x4*)(P.in(I_GNORM) + l * 128 + 16 * (4 * eh + 1) + 4 * g),
                gn2 = *(const f32x4*)(P.in(I_GNORM) + l * 128 + 16 * (4 * eh + 2) + 4 * g), gn3 = *(const f32x4*)(P.in(I_GNORM) + l * 128 + 16 * (4 * eh + 3) + 4 * g);
#define G2_LOAD(P_, c_) g2_load_ops(P_##wf, P_##qgf, P_##qkf, P_##kf, P_##ut, P_##zz, P_##gl, UTb, WMb, QGb, KDTb, QKb, Z, GL, (cidx0 + (c_)) * 4 + h, (prompt ? (cidx0 + (c_)) * 64 : TP + b * 64) + 16 * it + r16, h, it, eh, w, r16, g)
    bf16x8 c_wf[4], c_qgf[4], c_qkf[2], c_kf[2], n_wf[4], n_qgf[4], n_qkf[2], n_kf[2]; u32x2 c_ut[4], c_zz[4], n_ut[4], n_zz[4]; float c_gl, n_gl;
    G2_LOAD(c_, 0);
    float glv = (lane < nch) ? GL[(cidx0 + lane) * 4 + h] : 0.f; asm volatile("" : "+v"(glv));
    for (int c = 0; c < nch; ++c) {
        const int tok0 = prompt ? (cidx0 + c) * 64 : TP + b * 64;
        if (c + 1 < nch) G2_LOAD(n_, c + 1);
        {
#pragma unroll
            for (int ee = 0; ee < 4; ++ee) { const int et = 4 * eh + ee; f32x4 a = {0.f, 0.f, 0.f, 0.f};
#pragma unroll
                for (int ks = 0; ks < 4; ++ks) a = mfma16(c_wf[ks], lfrag(lds + cur, 16 * et + r16, 288, ks * 32 + 8 * g), a);
                const u32x2 u = c_ut[ee];
                u32x2 o; o.x = pk2(bf2f(u.x & 0xffffu) - a[0], bf2f(u.x >> 16) - a[1]); o.y = pk2(bf2f(u.y & 0xffffu) - a[2], bf2f(u.y >> 16) - a[3]);
                *(LAS u32x2*)(lds + G2_VNT + (16 * et + r16) * 160 + (16 * it + 4 * g) * 2) = o; } }
        LDS_BARRIER();
        f32x4 o4[4];
        { float ss = 0.f;
#pragma unroll
            for (int ee = 0; ee < 4; ++ee) { const int et = 4 * eh + ee; f32x4 a = {0.f, 0.f, 0.f, 0.f};
#pragma unroll
                for (int ks = 0; ks < 4; ++ks) a = mfma16(lfrag(lds + cur, 16 * et + r16, 288, ks * 32 + 8 * g), c_qgf[ks], a);
#pragma unroll
                for (int ks = 0; ks < 2; ++ks) a = mfma16(lfrag(lds + G2_VNT, 16 * et + r16, 160, ks * 32 + 8 * g), c_qkf[ks], a);
                o4[ee] = a; ss += (a[0] * a[0] + a[1] * a[1]) + (a[2] * a[2] + a[3] * a[3]); }
            ss += __shfl_xor(ss, 16); ss += __shfl_xor(ss, 32);
            if (g == 0) stat[(16 * it + r16) * 2 + eh] = ss; }
        { const float gl = __builtin_bit_cast(float, __builtin_amdgcn_readlane(__builtin_bit_cast(int, glv), c));
#pragma unroll
            for (int et = 0; et < 8; ++et) { f32x4 a = S[et] * gl;
#pragma unroll
                for (int ks = 0; ks < 2; ++ks) a = mfma16(c_kf[ks], lfrag(lds + G2_VNT, 16 * et + r16, 160, ks * 32 + 8 * g), a);
                S[et] = a; u32x2 o; o.x = pk2(a[0], a[1]); o.y = pk2(a[2], a[3]); *(LAS u32x2*)(lds + nxt + (16 * et + r16) * 288 + (16 * w + 4 * g) * 2) = o; } }
        LDS_BARRIER();
        { const int i = 16 * it + r16, tok = tok0 + i; const float rn = rsqrtf((stat[i * 2] + stat[i * 2 + 1]) * (1.0f / 128.0f) + EPS);
#pragma unroll
            for (int ee = 0; ee < 4; ++ee) { const int e = 16 * (4 * eh + ee) + 4 * g; const u32x2 zz = c_zz[ee]; const f32x4 gn = ee == 0 ? gn0 : ee == 1 ? gn1 : ee == 2 ? gn2 : gn3;
                const float z0 = bf2f(zz.x & 0xffffu), z1 = bf2f(zz.x >> 16), z2 = bf2f(zz.y & 0xffffu), z3 = bf2f(zz.y >> 16);
                u32x2 o; o.x = pk2(o4[ee][0] * rn * gn[0] * (z0 / (1.f + __expf(-z0))), o4[ee][1] * rn * gn[1] * (z1 / (1.f + __expf(-z1))));
                o.y = pk2(o4[ee][2] * rn * gn[2] * (z2 / (1.f + __expf(-z2))), o4[ee][3] * rn * gn[3] * (z3 / (1.f + __expf(-z3))));
                *(u32x2*)(MIX + (size_t)tok * DM + h * 128 + e) = o; } }
        if (c + 1 < nch) {
#pragma unroll
            for (int k = 0; k < 4; ++k) { c_wf[k] = n_wf[k]; c_qgf[k] = n_qgf[k]; c_ut[k] = n_ut[k]; c_zz[k] = n_zz[k]; }
#pragma unroll
            for (int k = 0; k < 2; ++k) { c_qkf[k] = n_qkf[k]; c_kf[k] = n_kf[k]; }
            c_gl = n_gl; }
        const int tmp = cur; cur = nxt; nxt = tmp;
    }
    float* so = prompt ? P.out() + O_GP + ((size_t)(l * 16 + b) * 4 + h) * 16384 : P.out() + O_GS + ((size_t)(l * 8 + b) * 4 + h) * 16384;
#pragma unroll
    for (int et = 0; et < 8; ++et)
#pragma unroll
        for (int rg = 0; rg < 4; ++rg) so[(16 * w + 4 * g + rg) * 128 + 16 * et + r16] = S[et][rg];
    __syncthreads();
}

__device__ __forceinline__ int perm32(int rho) { const int n = rho >> 4, i = rho & 15; return 8 * (i >> 2) + 4 * n + (i & 3); }
template <int DQK, int DV, int QT, int KT, bool DIFF>
__device__ __forceinline__ void attn_unit(LAS unsigned char* lds, const bf16* Kg, int ldk, const bf16* VTg, int ldv, const bf16* Qg, int ldq, int ntile_total, int ntile_w, bool active,
                                          float sc, float lam, float oscale, const float* dnorm, bf16* Og, int ldo) {
    constexpr int KW = DIFF ? 2 * DQK : DQK, KSTR = KW * 2 + 32, KBYTES = KT * KSTR, VSTR = KT * 2 + 32, VBYTES = DV * VSTR, STAGE = KBYTES + VBYTES;
    constexpr int PPR = KW / 8, VPR = KT / 8, NET = DV / 16, NKS = DQK / 32, NG = KT / 32;
    static_assert(KT * PPR == 1024 && DV * VPR == 1024 && 2 * STAGE <= 131072, "staging geometry");
    const int tid = opaque_tid(), lane = tid & 63, w = tid >> 6, r16 = lane & 15, g = lane >> 4;
    const int wq = DIFF ? (w & 3) : w, cm = DIFF ? (w >> 2) : 0, qrow0 = wq * QT * 16;
    bf16x8 Qf[QT][NKS];
#pragma unroll
    for (int qt = 0; qt < QT; ++qt)
#pragma unroll
        for (int ks = 0; ks < NKS; ++ks) { if (active) Qf[qt][ks] = gfrag(Qg + (size_t)(qrow0 + qt * 16 + r16) * ldq + cm * DQK + ks * 32 + 8 * g); else Qf[qt][ks] = (bf16x8){0, 0, 0, 0, 0, 0, 0, 0}; }
    f32x4 O[QT][NET]; float mrow[QT], lrow[QT];
#pragma unroll
    for (int qt = 0; qt < QT; ++qt) { mrow[qt] = -INFINITY; lrow[qt] = 0.f;
#pragma unroll
        for (int et = 0; et < NET; ++et) O[qt][et] = (f32x4){0.f, 0.f, 0.f, 0.f}; }
    int ksrc[2], kdst[2], vsrc[2], vdst[2];
#pragma unroll
    for (int i = 0; i < 2; ++i) { const int pp = tid + 512 * i; const int rho = pp / PPR, cp = pp % PPR, key = (rho & ~31) + perm32(rho & 31); ksrc[i] = key * ldk + cp * 8; kdst[i] = rho * KSTR + cp * 16;
        const int e = pp / VPR, vp = pp % VPR; vsrc[i] = e * ldv + vp * 8; vdst[i] = KBYTES + e * VSTR + vp * 16; }
    u32x4 kr[2], vr[2];
#pragma unroll
    for (int i = 0; i < 2; ++i) { kr[i] = *(const u32x4*)(Kg + ksrc[i]); vr[i] = *(const u32x4*)(VTg + vsrc[i]); }
#pragma unroll
    for (int i = 0; i < 2; ++i) { *(LAS u32x4*)(lds + kdst[i]) = kr[i]; *(LAS u32x4*)(lds + vdst[i]) = vr[i]; }
    __syncthreads();
    for (int j = 0; j < ntile_total; ++j) {
        const LAS unsigned char* Kb = lds + (j & 1) * STAGE; const LAS unsigned char* Vb = Kb + KBYTES;
        if (j + 1 < ntile_total) {
#pragma unroll
            for (int i = 0; i < 2; ++i) { kr[i] = *(const u32x4*)(Kg + (size_t)(j + 1) * KT * ldk + ksrc[i]); vr[i] = *(const u32x4*)(VTg + (size_t)(j + 1) * KT + vsrc[i]); } }
        if (active && j < ntile_w) {
            f32x4 Sx[QT][NG][2];
            __builtin_amdgcn_s_setprio(1);
#pragma unroll
            for (int G = 0; G < NG; ++G)
#pragma unroll
                for (int t = 0; t < 2; ++t) {
#pragma unroll
                    for (int qt = 0; qt < QT; ++qt) Sx[qt][G][t] = (f32x4){0.f, 0.f, 0.f, 0.f};
#pragma unroll
                    for (int ks = 0; ks < NKS; ++ks) { const bf16x8 a = lfrag(Kb, 32 * G + 16 * t + r16, KSTR, cm * DQK + ks * 32 + 8 * g);
#pragma unroll
                        for (int qt = 0; qt < QT; ++qt) Sx[qt][G][t] = mfma16(a, Qf[qt][ks], Sx[qt][G][t]); } }
            __builtin_amdgcn_s_setprio(0);
            bf16x8 pb[QT][NG];
#pragma unroll
            for (int qt = 0; qt < QT; ++qt) { float mx = -INFINITY;
#pragma unroll
                for (int G = 0; G < NG; ++G)
#pragma unroll
                    for (int t = 0; t < 2; ++t)
#pragma unroll
                        for (int rg = 0; rg < 4; ++rg) mx = fmaxf(mx, Sx[qt][G][t][rg]);
                mx = fmaxf(mx, __shfl_xor(mx, 16)); mx = fmaxf(mx, __shfl_xor(mx, 32)); mx *= sc;
                const float mnew = fmaxf(mrow[qt], mx), alpha = __builtin_amdgcn_exp2f(mrow[qt] - mnew), nm = -mnew; mrow[qt] = mnew; float ps = 0.f;
#pragma unroll
                for (int G = 0; G < NG; ++G) { float pv[8];
#pragma unroll
                    for (int t = 0; t < 2; ++t)
#pragma unroll
                        for (int rg = 0; rg < 4; ++rg) { const float e = __builtin_amdgcn_exp2f(fmaf(Sx[qt][G][t][rg], sc, nm)); pv[4 * t + rg] = e; ps += e; }
                    u32x4 pk; pk.x = pk2(pv[0], pv[1]); pk.y = pk2(pv[2], pv[3]); pk.z = pk2(pv[4], pv[5]); pk.w = pk2(pv[6], pv[7]); pb[qt][G] = __builtin_bit_cast(bf16x8, pk); }
                lrow[qt] = lrow[qt] * alpha + ps;
                if (__builtin_amdgcn_ballot_w64(alpha != 1.0f) != 0ull) {
#pragma unroll
                    for (int et = 0; et < NET; ++et) O[qt][et] *= alpha; } }
            __builtin_amdgcn_s_setprio(1);
#pragma unroll
            for (int et = 0; et < NET; ++et)
#pragma unroll
                for (int G = 0; G < NG; ++G) { const bf16x8 a = lfrag(Vb, 16 * et + r16, VSTR, 32 * G + 8 * g);
#pragma unroll
                    for (int qt = 0; qt < QT; ++qt) O[qt][et] = mfma16(a, pb[qt][G], O[qt][et]); }
            __builtin_amdgcn_s_setprio(0);
        }
        if (j + 1 < ntile_total) { LAS unsigned char* nb = lds + ((j + 1) & 1) * STAGE;
#pragma unroll
            for (int i = 0; i < 2; ++i) { *(LAS u32x4*)(nb + kdst[i]) = kr[i]; *(LAS u32x4*)(nb + vdst[i]) = vr[i]; } }
        __syncthreads();
    }
    if (active) {
#pragma unroll
        for (int qt = 0; qt < QT; ++qt) { float lt = lrow[qt]; lt += __shfl_xor(lt, 16); lt += __shfl_xor(lt, 32); const float inv = 1.f / lt;
#pragma unroll
            for (int et = 0; et < NET; ++et) O[qt][et] *= inv; } }
    if constexpr (DIFF) {
        LAS f32x4* ex = (LAS f32x4*)lds;
        if (active && cm == 1) {
#pragma unroll
            for (int qt = 0; qt < QT; ++qt)
#pragma unroll
                for (int et = 0; et < NET; ++et) ex[((wq * QT + qt) * NET + et) * 64 + lane] = O[qt][et]; }
        __syncthreads();
        if (active && cm == 0) {
#pragma unroll
            for (int qt = 0; qt < QT; ++qt) { float ss = 0.f;
#pragma unroll
                for (int et = 0; et < NET; ++et) { const f32x4 o2 = ex[((wq * QT + qt) * NET + et) * 64 + lane]; const f32x4 o = O[qt][et] - o2 * lam; O[qt][et] = o; ss += (o[0] * o[0] + o[1] * o[1]) + (o[2] * o[2] + o[3] * o[3]); }
                ss += __shfl_xor(ss, 16); ss += __shfl_xor(ss, 32); const float rn = rsqrtf(ss * (1.0f / DV) + EPS) * oscale;
                bf16* orow = Og + (size_t)(qrow0 + qt * 16 + r16) * ldo;
#pragma unroll
                for (int et = 0; et < NET; ++et) { const f32x4 gn = *(const f32x4*)(dnorm + 16 * et + 4 * g); const f32x4 o = O[qt][et]; u32x2 pk; pk.x = pk2(o[0] * rn * gn[0], o[1] * rn * gn[1]); pk.y = pk2(o[2] * rn * gn[2], o[3] * rn * gn[3]);
                    *(u32x2*)(orow + 16 * et + 4 * g) = pk; } } }
        __syncthreads();
    } else {
        if (active) {
#pragma unroll
            for (int qt = 0; qt < QT; ++qt) { bf16* orow = Og + (size_t)(qrow0 + qt * 16 + r16) * ldo;
#pragma unroll
                for (int et = 0; et < NET; ++et) { const f32x4 o = O[qt][et]; u32x2 pk; pk.x = pk2(o[0], o[1]); pk.y = pk2(o[2], o[3]); *(u32x2*)(orow + 16 * et + 4 * g) = pk; } } }
    }
}
__device__ __forceinline__ float lam_full(const LP P, int l, int lane, float lam_init) {
    const float a = wave_sum(P.in(I_LQ1)[l * 64 + lane] * P.in(I_LK1)[l * 64 + lane]), b = wave_sum(P.in(I_LQ2)[l * 64 + lane] * P.in(I_LK2)[l * 64 + lane]);
    return __expf(a) - __expf(b) + lam_init;
}
enum { M_IN = 0, M_RES = 1, M_ROW = 2, M_ROWSQ = 3, M_MEMKV = 4 };
struct EpiU {
    static constexpr bool PERM = true, AFTER_DRAIN = false;
    int mode, l; LP P;
    __device__ __forceinline__ void operator()(const f32x4 (&acc)[2][2][4][2], const pg8::Unit& u, int wr, int wc, int fr, int fq) const {
        unsigned char* ws = P.ws(); float* outp = P.out(); float* SSQ = (float*)(ws + W_SSQ);
        if (mode == M_IN) { EpiIn e{SSQ, (bf16*)(ws + W_PROJ), (bf16*)(ws + W_PVT), (bf16*)(ws + W_SVT) + (size_t)l * 32 * 128 * 2112, (bf16*)(ws + W_SK) + (size_t)l * 8 * 2112 * 512,
                                    outp + O_KP + (size_t)l * TP * 512, outp + O_VP + (size_t)l * TP * 512, outp + O_KS + (size_t)l * TS * 512, outp + O_VS + (size_t)l * TS * 512}; e(acc, u, wr, wc, fr, fq); }
        else if (mode == M_RES) { EpiRes e{outp + O_Y, (bf16*)(ws + W_HB), SSQ}; e(acc, u, wr, wc, fr, fq); }
        else if (mode == M_ROW) { EpiRow<0> e{SSQ, (bf16*)(ws + W_QM), DM}; e(acc, u, wr, wc, fr, fq); }
        else if (mode == M_ROWSQ) { EpiRow<1> e{SSQ, (bf16*)(ws + W_FH), DFF}; e(acc, u, wr, wc, fr, fq); }
        else { EpiMemKV e{(const float*)(ws + W_RINVM), outp + O_MKP, outp + O_MVP, (bf16*)(ws + W_MKB), (bf16*)(ws + W_MVT)}; e(acc, u, wr, wc, fr, fq); }
    }
};

__global__ void __launch_bounds__(512) mega_fwd(Params p) {
    extern __shared__ __attribute__((aligned(16))) unsigned char lds_raw[];
    LAS unsigned char* lds = (LAS unsigned char*)lds_raw;
    cg::grid_group grid = cg::this_grid();
    const int G = gridDim.x, bx = blockIdx.x;
    { const int tid = threadIdx.x;
    if (tid == 0) { LAS unsigned long long* q = (LAS unsigned long long*)(lds + LDS_PARAMS);
#pragma unroll
        for (int i = 0; i < 31; ++i) q[i] = (unsigned long long)p.in[i];
        q[31] = (unsigned long long)p.out; q[32] = (unsigned long long)p.ws; }
    if (tid < 2) ((volatile LAS unsigned*)(lds + LDS_PARAMS + 384))[tid] = 0u;
    }
    __syncthreads();
    const LP P{(volatile LAS const unsigned*)(lds + LDS_PARAMS)};
    grid.sync();
    (void)xcd_barrier_post((unsigned*)(P.ws() + W_CTL), (volatile LAS unsigned*)(lds + LDS_PARAMS + 384));
#define GRID_BAR() do { XcdBarrier bar_; bar_.bar = (unsigned*)(P.ws() + W_CTL); bar_.x = xb_xcc_id(); bar_.st = (volatile LAS unsigned*)(lds + LDS_PARAMS + 384); xcd_barrier(bar_); } while (0)
    #ifndef MAXPH
#define MAXPH (NL * 9)
#endif
    for (int ph = -2; ph < MAXPH; ++ph) {
        const int l = ph < 0 ? 0 : ph / 9, st = ph < 0 ? ph : ph % 9;
        unsigned char* ws = P.ws(); float* const outp = P.out();
        float* H = outp + O_Y; bf16* HB = (bf16*)(ws + W_HB); float* SSQ = (float*)(ws + W_SSQ); bf16* PROJ = (bf16*)(ws + W_PROJ); bf16* MIX = (bf16*)(ws + W_MIX);
        bf16* QM = (bf16*)(ws + W_QM); bf16* MA = (bf16*)(ws + W_MA); bf16* FH = (bf16*)(ws + W_FH);
        bf16* SVT_l = (bf16*)(ws + W_SVT) + (size_t)l * 32 * 128 * 2112; bf16* SK_l = (bf16*)(ws + W_SK) + (size_t)l * 8 * 2112 * 512;
        const float lam_init = 0.8f - 0.6f * __expf(-0.3f * (float)l);
#ifdef REPEAT_ST
        for (int rep = 0; rep < ((st == REPEAT_ST) ? 2 : 1); ++rep) {
#else
        {
#endif
        if (st == -2) phase0(P, lds);
        else if (st == 1 || st == 2) {
            const int tid = opaque_tid(), lane = tid & 63, w = tid >> 6;
            const float lam = lam_full(P, l, lane, lam_init); const float scd = 0.125f * 1.4426950408889634f; const float* dn = P.in(I_DNORM) + l * 128;
            const bf16* QD = PROJ + (size_t)4 * TT * 512; const bf16* KD = PROJ + (size_t)5 * TT * 512; const bf16* PVT = (const bf16*)(ws + W_PVT);
            unsigned* qctr = (unsigned*)(ws + W_CTL) + 3584 + 64 * l;
            volatile LAS int* slot = (volatile LAS int*)(lds + LDS_PARAMS + 400);
            int k = 0, pend = -1;
            for (;;) {
                int type, arg;
                if (pend >= 0) { type = 1; arg = 64 + pend; pend = -1; }
                else if (st == 1) { int it = bx + k * G; if (it >= 4096) break;
                    if (G == 256) it = ((k * 64 + (bx & 7) * 8 + (bx >> 5)) << 2) + ((bx >> 3) & 3);
                    ++k; type = 0; arg = it; }
                else if (bx + k * G < 64) { type = 1; arg = bx + k * G; ++k; }
                else {
                    if (tid == 0) *slot = (int)__hip_atomic_fetch_add(qctr, 1u, __ATOMIC_RELAXED, __HIP_MEMORY_SCOPE_AGENT);
                    __syncthreads();
                    const int u = *slot;
                    __syncthreads();
                    if (u >= 32 + 2048 + 32) break;
                    if (u < 32) { type = 0; arg = 4096 + u; pend = u; } else { type = 2; arg = u - 32; }
                }
                if (type == 0) g1_item(P, l, arg, lds);
                else if (type == 1) g2_item(P, l, arg, lds);
                else { const int u = arg; const bool isP = !(u >= 1024 && u < 1056);
                    const bf16 *Kg, *VTg, *Qg; bf16* Og; int ldv, ntt, ntw; bool act;
                    if (isP) { const int up = u < 1024 ? u : u - 32, qb = 31 - (up >> 6), bh = up & 63, b = bh >> 2, h = bh & 3;
                        Kg = KD + (size_t)b * 4096 * 512 + h * 128; VTg = PVT + (size_t)bh * 128 * 4096; ldv = 4096; Qg = QD + ((size_t)b * 4096 + 128 * qb) * 512 + h * 128;
                        ntt = 2 * qb + 2; ntw = 2 * qb + 1 + ((w & 3) >> 1); act = true; Og = MIX + ((size_t)b * 4096 + 128 * qb) * DM + 512 + h * 128; }
                    else { const int su = u - 1024, b = su >> 2, h = su & 3; Kg = SK_l + (size_t)b * 2112 * 512 + h * 128; VTg = SVT_l + (size_t)su * 128 * 2112; ldv = 2112; Qg = QD + ((size_t)TP + 64 * b) * 512 + h * 128;
                        ntt = 33; ntw = 33; act = (w & 3) < 2; Og = MIX + ((size_t)TP + 64 * b) * DM + 512 + h * 128; }
                    attn_unit<64, 128, 2, 64, true>(lds, Kg, 512, VTg, ldv, Qg, 512, ntt, ntw, act, scd, lam, 1.f - lam_init, dn, Og, DM); }
            }
        }
        else if (st == 5) {
            const int w = opaque_tid() >> 6;
            const float scm = 0.0625f * 1.4426950408889634f;
            for (int u = bx; u < 2048 + 32; u += G) { const bf16 *Kg, *VTg, *Qg; bf16* Og; bool act;
                if (u < 2048) { const int tb = u >> 2, h = u & 3, b = tb >> 5; Kg = (const bf16*)(ws + W_MKB) + ((size_t)l * 4096 + b * 256) * DM + h * 256; VTg = (const bf16*)(ws + W_MVT) + ((size_t)(l * 16 + b) * 4 + h) * 65536;
                    Qg = QM + (size_t)tb * 128 * DM + h * 256; Og = MA + (size_t)tb * 128 * DM + h * 256; act = true; }
                else { const int v = u - 2048, b = v >> 2, h = v & 3; Kg = (const bf16*)(ws + W_CMK) + ((size_t)(l * 8 + b) * 256) * DM + h * 256; VTg = (const bf16*)(ws + W_CMVT) + ((size_t)(l * 8 + b) * 4 + h) * 65536;
                    Qg = QM + ((size_t)TP + 64 * b) * DM + h * 256; Og = MA + ((size_t)TP + 64 * b) * DM + h * 256; act = w < 4; }
                attn_unit<256, 256, 1, 32, false>(lds, Kg, DM, VTg, 256, Qg, DM, 8, 8, act, scm, 0.f, 0.f, nullptr, Og, DM); }
        }
        else {
            EpiU E{0, l, P}; const bf16* A; const bf16* Bt; int M = TT, N = DM, K = DM;
            if (st == -1) { E.mode = M_MEMKV; A = (const bf16*)(ws + W_MEMB); Bt = (const bf16*)(ws + W_WKV); M = 4096; N = NL * 2048; }
            else if (st == 0) { E.mode = M_IN; A = HB; Bt = (const bf16*)(ws + W_WIN) + (size_t)l * NIN * DM; N = NIN; }
            else if (st == 3) { E.mode = M_RES; A = MIX; Bt = (const bf16*)(ws + W_WOUT) + (size_t)l * DM * DM; }
            else if (st == 4) { E.mode = M_ROW; A = HB; Bt = (const bf16*)(ws + W_WQ) + (size_t)l * DM * DM; }
            else if (st == 6) { E.mode = M_RES; A = MA; Bt = (const bf16*)(ws + W_WO) + (size_t)l * DM * DM; }
            else if (st == 7) { E.mode = M_ROWSQ; A = HB; Bt = (const bf16*)(ws + W_W1) + (size_t)l * DFF * DM; N = DFF; }
            else { E.mode = M_RES; A = FH; Bt = (const bf16*)(ws + W_W2) + (size_t)l * DM * DFF; K = DFF; }
            pg8::Gemm g{A, Bt, M, N, K}; pg8::StaticOrder S; S.init(M, N, G, bx);
            pg8::gemm_phase<EpiU, pg8::StaticOrder, true, true>(lds, g, S, E);
        }
        if (st != -1) GRID_BAR();
#ifdef DOUBLE_BAR
        GRID_BAR();
#endif
        }
    }
#ifdef DIAG_DUMP_G1
    {
        const int tid = opaque_tid(); unsigned char* ws = P.ws(); float* o = P.out(); const size_t SL = (size_t)TP * 512;
        const bf16* srcs[5] = {(const bf16*)(ws + W_UT), (const bf16*)(ws + W_WM), (const bf16*)(ws + W_QG), (const bf16*)(ws + W_KDT), (const bf16*)(ws + W_QK)};
        float* dsts[5] = {o + O_KP + SL, o + O_KP + 2 * SL, o + O_KP + 3 * SL, o + O_VP + SL, o + O_VP + 2 * SL};
#pragma unroll
        for (int k = 0; k < 5; ++k) { if (!((DIAG_DUMP_G1 >> k) & 1)) continue; const size_t n = k < 4 ? SL : (size_t)NITEM * 4096; for (size_t i = (size_t)bx * 512 + tid; i < n; i += (size_t)G * 512) dsts[k][i] = bf2f(srcs[k][i]); }
        if (DIAG_DUMP_G1 & 32) for (size_t i = (size_t)bx * 512 + tid; i < NITEM; i += (size_t)G * 512) (o + O_VP + 3 * SL)[i] = ((const float*)(ws + W_GL))[i];
    }
#endif
    { const int tid = opaque_tid(), lane = tid & 63, w = tid >> 6; float* Y = P.out() + O_Y; const bf16* HBf = (const bf16*)(P.ws() + W_HB); const int gw = bx * 8 + w, NGW = G * 8; const f32x4* gf = (const f32x4*)P.in(I_LNF);
        for (int m = gw; m < TT; m += NGW) { const u32x4* hr = (const u32x4*)(HBf + (size_t)m * DM) + lane; f32x4 v[4]; float s = 0.f;
#pragma unroll
            for (int j = 0; j < 2; ++j) { const u32x4 hv = hr[64 * j]; v[2 * j][0] = bf2f(hv.x & 0xffffu); v[2 * j][1] = bf2f(hv.x >> 16); v[2 * j][2] = bf2f(hv.y & 0xffffu); v[2 * j][3] = bf2f(hv.y >> 16);
                v[2 * j + 1][0] = bf2f(hv.z & 0xffffu); v[2 * j + 1][1] = bf2f(hv.z >> 16); v[2 * j + 1][2] = bf2f(hv.w & 0xffffu); v[2 * j + 1][3] = bf2f(hv.w >> 16); }
#pragma unroll
            for (int j = 0; j < 4; ++j) s += (v[j][0] * v[j][0] + v[j][1] * v[j][1]) + (v[j][2] * v[j][2] + v[j][3] * v[j][3]);
            const float rn = rsqrtf(wave_sum(s) * (1.0f / 1024.0f) + EPS);
            f32x4* yr = (f32x4*)(Y + (size_t)m * DM);
#pragma unroll
            for (int j = 0; j < 2; ++j) { const int c4 = 2 * lane + 128 * j; yr[c4] = v[2 * j] * rn * gf[c4]; yr[c4 + 1] = v[2 * j + 1] * rn * gf[c4 + 1]; } } }
}

extern "C" void kernel_launch(void* const* d_in, const int* in_sizes, int n_in, void* d_out, int out_size, void* d_ws, size_t ws_size, hipStream_t stream) {
    static int grid = 0;
    if (grid == 0) {
        if (n_in != 31 || (size_t)out_size != O_END || ws_size < W_END) { fprintf(stderr, "kernel_launch: unexpected shapes (n_in %d out %d ws %zu need %zu)\n", n_in, out_size, ws_size, (size_t)W_END); grid = -1; return; }
        int dev = 0, cus = 0, per_cu = 0;
        (void)hipGetDevice(&dev); (void)hipDeviceGetAttribute(&cus, hipDeviceAttributeMultiprocessorCount, dev);
        if (hipFuncSetAttribute((const void*)mega_fwd, hipFuncAttributeMaxDynamicSharedMemorySize, LDS_BYTES) != hipSuccess) { fprintf(stderr, "kernel_launch: hipFuncSetAttribute failed\n"); }
        if (hipOccupancyMaxActiveBlocksPerMultiprocessor(&per_cu, (const void*)mega_fwd, 512, LDS_BYTES) != hipSuccess || per_cu < 1) { fprintf(stderr, "kernel_launch: occupancy query says %d\n", per_cu); per_cu = 1; }
        (void)hipGetLastError();
        grid = cus * 1;
    }
    if (grid < 0) return;
    (void)hipMemsetAsync((unsigned char*)d_ws + W_CTL, 0, CTL_BYTES, stream);
    Params p{};
    for (int i = 0; i < 31; ++i) p.in[i] = (const float*)d_in[i];
    p.out = (float*)d_out; p.ws = (unsigned char*)d_ws;
    void* args[] = {&p};
    hipError_t e = hipLaunchCooperativeKernel((const void*)mega_fwd, dim3(grid), dim3(512), args, LDS_BYTES, stream);
    if (e != hipSuccess) fprintf(stderr, "kernel_launch: cooperative launch failed: %s (grid %d)\n", hipGetErrorString(e), grid);
}
```
